# Optimizing an MI355X kernel written in HIP

```python
import jax, jax.numpy as jnp
from jax import lax
import numpy as np

D_MODEL = 1024
BATCH = 8
SEQ = 2048
DEPTH = 2
DEC_BATCH = 8
DEC_SEQ = 64
PAST_LEN = 2048

CHUNK = 64
EPS = 1e-6
N_BRANCH = 3
POOL_WINDOWS = (2, 4, 8, 16)
POOL_GROUPS = 4
POOL_GW = D_MODEL // 8
D_A = POOL_GROUPS * POOL_GW
POOL_HIST = 16 - 1
SGU_LEN = 128
SGU_GROUPS = 4
D_B = D_MODEL // 2
SGU_GW = D_B // SGU_GROUPS
GLA_HEADS = 4
GLA_DK = D_MODEL // 2 // GLA_HEADS
GLA_DV = D_MODEL // GLA_HEADS
D_CK = GLA_HEADS * GLA_DK
D_CV = GLA_HEADS * GLA_DV
GLA_RANK = 16
GLA_NORMALIZER = 16.0
GLA_BLOCK = CHUNK // 4
SPLIT_SIZES = (D_A, D_A, D_B, D_B, D_B, D_CK, D_CK, D_CV, D_CV, GLA_RANK, N_BRANCH * D_MODEL)
D_IN = 2 * D_A + 3 * D_B + 2 * D_CK + 2 * D_CV + GLA_RANK + N_BRANCH * D_MODEL

kernel_name = "hybrid_pool_sgu_gla_streaming_step"


def rmsnorm(x, g):
    xf = x.astype(jnp.float32)
    y = xf * lax.rsqrt(jnp.mean(xf * xf, axis=-1, keepdims=True) + EPS)
    return (y * g.astype(jnp.float32)).astype(x.dtype)


def layernorm(x, g):
    xf = x.astype(jnp.float32)
    mu = jnp.mean(xf, axis=-1, keepdims=True)
    xc = xf - mu
    y = xc * lax.rsqrt(jnp.mean(xc * xc, axis=-1, keepdims=True) + EPS)
    return (y * g.astype(jnp.float32)).astype(x.dtype)


def split_cols(z):
    idx = [int(i) for i in np.cumsum(SPLIT_SIZES)[:-1]]
    return jnp.split(z, idx, axis=-1)


def ada_modulation(c, w, b):
    mod = (jax.nn.silu(c) @ w + b)[:, None, :]
    shift, scale, gate = jnp.split(mod, 3, axis=-1)
    return shift, scale, gate


def pool_mixer(a, hist, pos0, pool_w, pool_scale):
    B, T, _ = a.shape
    full = jnp.concatenate([hist, a], axis=1)
    ff = full.astype(jnp.float32)
    cs = jnp.concatenate([jnp.zeros((B, 1, D_A), jnp.float32), jnp.cumsum(ff, axis=1)], axis=1)
    end = cs[:, POOL_HIST + 1:]
    pos = pos0 + jnp.arange(T)
    means = []
    for gi, w in enumerate(POOL_WINDOWS):
        sl = slice(gi * POOL_GW, (gi + 1) * POOL_GW)
        start = cs[:, POOL_HIST + 1 - w: POOL_HIST + 1 - w + T, sl]
        cnt = jnp.minimum(w, pos + 1).astype(jnp.float32)[None, :, None]
        means.append((end[..., sl] - start) / cnt)
    d = (jnp.concatenate(means, axis=-1) - ff[:, POOL_HIST:]).astype(a.dtype)
    d = d.reshape(B, T, POOL_GROUPS, POOL_GW)
    y = jnp.einsum('btgc,gcd->btgd', d, pool_w).reshape(B, T, D_A) * pool_scale
    new_hist = full[:, -POOL_HIST:]
    return y, new_hist


def sgu_mixer(u, v, norm_g, w_s, b_s):
    B, T, _ = v.shape
    L = min(T, SGU_LEN)
    nc = T // L
    vn = layernorm(v, norm_g)
    vr = vn.reshape(B, nc, L, SGU_GROUPS, SGU_GW)
    wm = jnp.tril(w_s[:, :L, :L])
    bias = b_s[:, :L].T[None, None, :, :, None]
    s = jnp.einsum('gij,bnjgc->bnigc', wm, vr) + bias
    return u * s.reshape(B, T, D_B), vn


def gla_scan(q, k, v, log_a, s0):
    B, T = q.shape[0], q.shape[1]
    pad = (-T) % GLA_BLOCK
    padt = lambda t: jnp.pad(t.astype(jnp.float32), ((0, 0), (0, pad), (0, 0), (0, 0)))

    def to_blocks(t):
        Tp, H, X = t.shape[1], t.shape[2], t.shape[3]
        return t.reshape(B, Tp // GLA_BLOCK, GLA_BLOCK, H, X).transpose(1, 0, 3, 2, 4)

    qb, kb, vb, gb = (to_blocks(padt(t)) for t in (q, k, v, log_a))
    mask = jnp.tril(jnp.ones((GLA_BLOCK, GLA_BLOCK), bool))[:, :, None]

    def step(S, inp):
        qi, ki, vi, gi = inp
        bc = jnp.cumsum(gi, axis=2)
        diff = bc[:, :, :, None, :] - bc[:, :, None, :, :]
        decay = jnp.where(mask, jnp.exp(jnp.where(mask, diff, 0.0)), 0.0)
        att = jnp.einsum('bhid,bhjd,bhijd->bhij', qi, ki, decay)
        o = jnp.einsum('bhij,bhjv->bhiv', att, vi) + jnp.einsum('bhid,bhdv->bhiv', qi * jnp.exp(bc), S)
        blast = bc[:, :, -1]
        kdec = ki * jnp.exp(blast[:, :, None, :] - bc)
        S = jnp.exp(blast)[..., None] * S + jnp.einsum('bhjd,bhjv->bhdv', kdec, vi)
        return S, o

    s_fin, ob = lax.scan(step, s0.astype(jnp.float32), (qb, kb, vb, gb))
    o = ob.transpose(1, 0, 3, 2, 4).reshape(B, T + pad, GLA_HEADS, GLA_DV)[:, :T]
    return o.astype(v.dtype), s_fin.astype(s0.dtype)


def mixer_layer(x, c, pool_hist, gla_state, pos0, lp):
    (ada_w, ada_b, pre_g, post_g, w_in, pool_w, pool_scale, sgu_g, sgu_w, sgu_b,
     wa2, ba, gla_g, w_oa, w_ob, w_oc, w_out) = lp
    B, T, _ = x.shape
    shift, scale, gate = ada_modulation(c, ada_w, ada_b)
    h = rmsnorm(x, pre_g) * (1.0 + scale) + shift
    z = h @ w_in
    a, g_a, u, v_b, g_b, q, k, v_c, g_c, z_lr, g_m = split_cols(z)
    y_a, new_hist = pool_mixer(a, pool_hist, pos0, pool_w, pool_scale)
    y_a = y_a * jax.nn.silu(g_a)
    y_b, v_rows = sgu_mixer(u, v_b, sgu_g, sgu_w, sgu_b)
    y_b = y_b * jax.nn.silu(g_b)
    log_a = jax.nn.log_sigmoid((z_lr @ wa2 + ba).astype(jnp.float32)) / GLA_NORMALIZER
    heads = lambda t, d: t.reshape(B, T, GLA_HEADS, d)
    o, new_state = gla_scan(heads(q, GLA_DK) * (GLA_DK ** -0.5), heads(k, GLA_DK),
                            heads(v_c, GLA_DV), heads(log_a, GLA_DK), gla_state)
    y_c = rmsnorm(o, gla_g).reshape(B, T, D_CV) * jax.nn.silu(g_c)
    gm = jax.nn.sigmoid(g_m)
    m = (gm[..., :D_MODEL] * (y_a @ w_oa)
         + gm[..., D_MODEL:2 * D_MODEL] * (y_b @ w_ob)
         + gm[..., 2 * D_MODEL:] * (y_c @ w_oc))
    out = m @ w_out
    x = x + gate * rmsnorm(out, post_g)
    return x, new_hist, new_state, v_rows


def setup_inputs(seed: int = 0) -> dict:
    key = jax.random.key(seed)
    ks = jax.random.split(key, 26)
    nrm = lambda k, shape, s: jax.random.normal(k, shape, jnp.float32) * s
    D = D_MODEL
    return {
        "x_prompt": nrm(ks[0], (BATCH, SEQ, D), 1.0),
        "x_sample": nrm(ks[1], (DEC_BATCH, DEC_SEQ, D), 1.0),
        "state_pool": nrm(ks[2], (DEPTH, DEC_BATCH, POOL_HIST, D_A), 1.0),
        "state_gla": nrm(ks[3], (DEPTH, DEC_BATCH, GLA_HEADS, GLA_DK, GLA_DV), 1.0),
        "c_prompt": nrm(ks[4], (BATCH, D), 1.0),
        "c_sample": nrm(ks[5], (DEC_BATCH, D), 1.0),
        "ada_w": nrm(ks[6], (DEPTH, D, 3 * D), 0.3 * D ** -0.5),
        "ada_b": nrm(ks[7], (DEPTH, 3 * D), 0.1),
        "pre_norm_g": 1.0 + nrm(ks[8], (DEPTH, D), 0.05),
        "post_norm_g": 1.0 + nrm(ks[9], (DEPTH, D), 0.05),
        "w_in": nrm(ks[10], (DEPTH, D, D_IN), D ** -0.5),
        "pool_w": nrm(ks[11], (DEPTH, POOL_GROUPS, POOL_GW, POOL_GW), POOL_GW ** -0.5),
        "pool_scale": 1.0 + nrm(ks[12], (DEPTH, D_A), 0.1),
        "sgu_norm_g": 1.0 + nrm(ks[13], (DEPTH, D_B), 0.05),
        "sgu_w": nrm(ks[14], (DEPTH, SGU_GROUPS, SGU_LEN, SGU_LEN), SGU_LEN ** -0.5),
        "sgu_b": 1.0 + nrm(ks[15], (DEPTH, SGU_GROUPS, SGU_LEN), 0.1),
        "gla_wa2": nrm(ks[16], (DEPTH, GLA_RANK, D_CK), GLA_RANK ** -0.5),
        "gla_ba": nrm(ks[17], (DEPTH, D_CK), 0.1),
        "gla_norm_g": 1.0 + nrm(ks[18], (DEPTH, GLA_DV), 0.05),
        "w_oa": nrm(ks[19], (DEPTH, D_A, D), D_A ** -0.5),
        "w_ob": nrm(ks[20], (DEPTH, D_B, D), D_B ** -0.5),
        "w_oc": nrm(ks[21], (DEPTH, D_CV, D), D_CV ** -0.5),
        "w_out": nrm(ks[22], (DEPTH, D, D), D ** -0.5),
    }


def reference(x_prompt, x_sample, state_pool, state_gla, c_prompt, c_sample,
              ada_w, ada_b, pre_norm_g, post_norm_g, w_in, pool_w, pool_scale,
              sgu_norm_g, sgu_w, sgu_b, gla_wa2, gla_ba, gla_norm_g,
              w_oa, w_ob, w_oc, w_out):
    params = (ada_w, ada_b, pre_norm_g, post_norm_g, w_in, pool_w, pool_scale,
              sgu_norm_g, sgu_w, sgu_b, gla_wa2, gla_ba, gla_norm_g,
              w_oa, w_ob, w_oc, w_out)
    xp, xs = x_prompt, x_sample
    bp = xp.shape[0]
    pool_p, gla_p, pool_s, gla_s, sgu_s = [], [], [], [], []
    for l in range(DEPTH):
        lp = tuple(p[l] for p in params)
        hist0 = jnp.zeros((bp, POOL_HIST, D_A), xp.dtype)
        s0 = jnp.zeros((bp, GLA_HEADS, GLA_DK, GLA_DV), state_gla.dtype)
        xp, hp, sp, _ = mixer_layer(xp, c_prompt, hist0, s0, 0, lp)
        xs, hs, ss, vs = mixer_layer(xs, c_sample, state_pool[l], state_gla[l], PAST_LEN, lp)
        pool_p.append(hp)
        gla_p.append(sp)
        pool_s.append(hs)
        gla_s.append(ss)
        sgu_s.append(vs)
    new_pool_prompt = jnp.stack(pool_p)
    new_gla_prompt = jnp.stack(gla_p)
    new_pool_sample = jnp.stack(pool_s)
    new_gla_sample = jnp.stack(gla_s)
    new_sgu_v_sample = jnp.stack(sgu_s)
    return (xp, xs, new_pool_prompt, new_gla_prompt, new_pool_sample, new_gla_sample, new_sgu_v_sample)
```

```cpp
#include <hip/hip_runtime.h>
#include <cstdio>
#include <cstdint>

#ifndef MK_N_LAUNCHES
#define MK_N_LAUNCHES 1
#endif

namespace pg8 {
#define PG8_LAS __attribute__((address_space(3)))
typedef unsigned short bf16_t;
typedef short bf16x8 __attribute__((ext_vector_type(8)));
typedef float f32x4 __attribute__((ext_vector_type(4)));
typedef unsigned u32x4 __attribute__((ext_vector_type(4)));
constexpr int BM = 256, BK = 64, HALF = 128, HTB = HALF * BK * 2, STAGE_BYTES = 8 * HTB, NXCD = 8, WGM = 8;

__host__ __device__ __forceinline__ int lds_byte(int r, int c) { const int st = (r >> 4) * 2 + (c >> 5), rr = r & 15, cc = c & 31, ob = rr * 64 + cc * 2; return st * 1024 + (ob ^ (((ob >> 9) & 1) << 5)); }
__host__ __device__ __forceinline__ void stage_rc(int b, int& R, int& C) { const int st = b / 1024, sb = b % 1024, swz = sb ^ (((sb >> 9) & 1) << 5); R = (st >> 1) * 16 + swz / 64; C = (st & 1) * 32 + (swz % 64) / 2; }
__host__ __device__ __forceinline__ int perm32(int rho) { const int n = rho >> 4, i = rho & 15; return 8 * (i >> 2) + 4 * n + (i & 3); }

struct Unit { int pm, pn; };
struct Gemm { const bf16_t* A; const bf16_t* Bt; int lda, ldb, K; };

struct StaticOrder {
    int nM, nN, nwg, G, c;
    __host__ __device__ void init(int nM_, int nN_, int G_, int c_) { nM = nM_; nN = nN_; nwg = nM * nN; G = G_; c = c_; }
    __host__ __device__ bool next(int i, Unit& u) const {
        const long L = (long)i * G + c; if (L >= nwg) return false;
        int wgid = (int)L; { const int q = nwg / NXCD, r = nwg % NXCD, xcd = wgid % NXCD, off = wgid / NXCD; wgid = (xcd < r ? xcd * (q + 1) : r * (q + 1) + (xcd - r) * q) + off; }
        const int nig = WGM * nN, gid = wgid / nig, fm = gid * WGM, gsz = (nM - fm) < WGM ? (nM - fm) : WGM;
        u.pm = fm + ((wgid % nig) % gsz); u.pn = (wgid % nig) / gsz; return true;
    }
};

typedef float f32x2_t __attribute__((ext_vector_type(2))); typedef __bf16 bf16x2_t __attribute__((ext_vector_type(2)));
__device__ __forceinline__ unsigned cvt_pk_bf16(float lo, float hi) { f32x2_t v = {lo, hi}; bf16x2_t b = __builtin_convertvector(v, bf16x2_t); return __builtin_bit_cast(unsigned, b); }
__device__ __forceinline__ float bflo(unsigned w) { return __uint_as_float(w << 16); }
__device__ __forceinline__ float bfhi(unsigned w) { return __uint_as_float(w & 0xffff0000u); }
__device__ __forceinline__ float sigmoidf_(float x) { return __builtin_amdgcn_rcpf(1.0f + __builtin_amdgcn_exp2f(-1.4426950408889634f * x)); }

struct EpiZ {
    static constexpr bool PERM = true, AFTER_DRAIN = false, KHOOK = false;
    bf16_t* Z; int ldz; float* pool_p; float* pool_s;
    __device__ __forceinline__ void operator()(const f32x4 (&acc)[2][2][4][2], const Unit& u, int wr, int wc, int fr, int fq) const {
        const int row0 = u.pm * BM + wr * 64 + fr, col0 = u.pn * BM + wc * 32 + 8 * fq;
#pragma unroll
        for (int ai = 0; ai < 2; ++ai)
#pragma unroll
            for (int m = 0; m < 4; ++m) {
                const int r = row0 + ai * HALF + m * 16; bf16_t* rowp = Z + (size_t)r * ldz + col0;
                float* prow = nullptr;
                if (u.pn < 2) {
                    if (r < 16384) { const int t = r & 2047; if (t >= 2033) prow = pool_p + (size_t)((r >> 11) * 15 + (t - 2033)) * 512; }
                    else { const int rs = r - 16384, t = rs & 63; if (t >= 49) prow = pool_s + (size_t)((rs >> 6) * 15 + (t - 49)) * 512; }
                }
#pragma unroll
                for (int bj = 0; bj < 2; ++bj) {
                    const f32x4 v0 = acc[ai][bj][m][0], v1 = acc[ai][bj][m][1];
                    u32x4 w; w.x = cvt_pk_bf16(v0[0], v0[1]); w.y = cvt_pk_bf16(v0[2], v0[3]); w.z = cvt_pk_bf16(v1[0], v1[1]); w.w = cvt_pk_bf16(v1[2], v1[3]);
                    *(u32x4*)(rowp + bj * HALF) = w;
                    if (prow) { *(f32x4*)(prow + col0 + bj * HALF) = v0; *(f32x4*)(prow + col0 + bj * HALF + 4) = v1; }
                }
            }
    }
};
struct EpiGm {
    static constexpr bool PERM = true, AFTER_DRAIN = false, KHOOK = false;
    bf16_t* Z; int ldz;
    __device__ __forceinline__ void operator()(const f32x4 (&acc)[2][2][4][2], const Unit& u, int wr, int wc, int fr, int fq) const {
        const int row0 = u.pm * BM + wr * 64 + fr, col0 = u.pn * BM + wc * 32 + 8 * fq;
#pragma unroll
        for (int ai = 0; ai < 2; ++ai)
#pragma unroll
            for (int m = 0; m < 4; ++m) {
                bf16_t* rowp = Z + (size_t)(row0 + ai * HALF + m * 16) * ldz + col0;
#pragma unroll
                for (int bj = 0; bj < 2; ++bj) {
                    const f32x4 v0 = acc[ai][bj][m][0], v1 = acc[ai][bj][m][1];
                    u32x4 w; w.x = cvt_pk_bf16(sigmoidf_(v0[0]), sigmoidf_(v0[1])); w.y = cvt_pk_bf16(sigmoidf_(v0[2]), sigmoidf_(v0[3]));
                    w.z = cvt_pk_bf16(sigmoidf_(v1[0]), sigmoidf_(v1[1])); w.w = cvt_pk_bf16(sigmoidf_(v1[2]), sigmoidf_(v1[3]));
                    *(u32x4*)(rowp + bj * HALF) = w;
                }
            }
    }
};
struct EpiMerge {
    static constexpr bool PERM = true, AFTER_DRAIN = false, KHOOK = true;
    const bf16_t* G; int ldg; bf16_t* Mo; int ldm;
    __device__ __forceinline__ void khook(f32x4 (&acc)[2][2][4][2], const Unit& u, int t, int wr, int wc, int fr, int fq) const {
        if (t != 8 && t != 16) return;
        const int br = (t == 8) ? 0 : 1;
        asm volatile("" : "+v"(fr), "+v"(fq));
        const int row0 = u.pm * BM + wr * 64 + fr, col0 = u.pn * BM + wc * 32 + 8 * fq;
#pragma unroll
        for (int ai = 0; ai < 2; ++ai)
#pragma unroll
            for (int m = 0; m < 4; ++m) {
                const bf16_t* gp = G + (size_t)(row0 + ai * HALF + m * 16) * ldg + br * 1024 + col0;
#pragma unroll
                for (int bj = 0; bj < 2; ++bj) {
                    const u32x4 nu = *(const u32x4*)(gp + bj * HALF), de = *(const u32x4*)(gp + 1024 + bj * HALF);
                    f32x4 r0, r1;
                    r0[0] = bflo(nu.x) * __builtin_amdgcn_rcpf(bflo(de.x)); r0[1] = bfhi(nu.x) * __builtin_amdgcn_rcpf(bfhi(de.x));
                    r0[2] = bflo(nu.y) * __builtin_amdgcn_rcpf(bflo(de.y)); r0[3] = bfhi(nu.y) * __builtin_amdgcn_rcpf(bfhi(de.y));
                    r1[0] = bflo(nu.z) * __builtin_amdgcn_rcpf(bflo(de.z)); r1[1] = bfhi(nu.z) * __builtin_amdgcn_rcpf(bfhi(de.z));
                    r1[2] = bflo(nu.w) * __builtin_amdgcn_rcpf(bflo(de.w)); r1[3] = bfhi(nu.w) * __builtin_amdgcn_rcpf(bfhi(de.w));
                    acc[ai][bj][m][0] *= r0; acc[ai][bj][m][1] *= r1;
                }
                asm volatile("" ::: "memory");
            }
    }
    __device__ __forceinline__ void operator()(const f32x4 (&acc)[2][2][4][2], const Unit& u, int wr, int wc, int fr, int fq) const {
        const int row0 = u.pm * BM + wr * 64 + fr, col0 = u.pn * BM + wc * 32 + 8 * fq;
#pragma unroll
        for (int ai = 0; ai < 2; ++ai)
#pragma unroll
            for (int m = 0; m < 4; ++m) {
                const int r = row0 + ai * HALF + m * 16;
                const bf16_t* gp = G + (size_t)r * ldg + 2048 + col0; bf16_t* rowp = Mo + (size_t)r * ldm + col0;
#pragma unroll
                for (int bj = 0; bj < 2; ++bj) {
                    const u32x4 g = *(const u32x4*)(gp + bj * HALF);
                    const f32x4 v0 = acc[ai][bj][m][0], v1 = acc[ai][bj][m][1];
                    u32x4 w; w.x = cvt_pk_bf16(v0[0] * bflo(g.x), v0[1] * bfhi(g.x)); w.y = cvt_pk_bf16(v0[2] * bflo(g.y), v0[3] * bfhi(g.y));
                    w.z = cvt_pk_bf16(v1[0] * bflo(g.z), v1[1] * bfhi(g.z)); w.w = cvt_pk_bf16(v1[2] * bflo(g.w), v1[3] * bfhi(g.w));
                    *(u32x4*)(rowp + bj * HALF) = w;
                }
            }
    }
};
struct EpiF32 {
    static constexpr bool PERM = false, AFTER_DRAIN = false, KHOOK = false;
    float* C; int ldc;
    __device__ __forceinline__ void operator()(const f32x4 (&acc)[2][2][4][2], const Unit& u, int wr, int wc, int fr, int fq) const {
        const int row0 = u.pm * BM + wr * 64 + fr, col0 = u.pn * BM + wc * 32 + 4 * fq;
#pragma unroll
        for (int ai = 0; ai < 2; ++ai)
#pragma unroll
            for (int m = 0; m < 4; ++m) { float* rowp = C + (size_t)(row0 + ai * HALF + m * 16) * ldc + col0;
#pragma unroll
                for (int bj = 0; bj < 2; ++bj)
#pragma unroll
                    for (int n = 0; n < 2; ++n) *(f32x4*)(rowp + bj * HALF + n * 16) = acc[ai][bj][m][n]; }
    }
};

template <class Epi, class Sched, bool ALIGN_EPI>
__device__ __forceinline__ void gemm_phase(PG8_LAS unsigned char* lds, const Gemm g, const Sched& S, const Epi& E) {
    int tid_ = threadIdx.x; asm volatile("" : "+v"(tid_));
    const int tid = tid_, wid = __builtin_amdgcn_readfirstlane(tid >> 6), lane = tid & 63, wr = wid >> 2, wc = wid & 3, fr = lane & 15, fq = lane >> 4;
    const int K = g.K, nt = K / BK;
    unsigned voffA[2], voffB[2];
#pragma unroll
    for (int i = 0; i < 2; ++i) { int R, C; stage_rc(tid * 16 + i * 8192, R, C); const int Rb = Epi::PERM ? ((R & ~31) + perm32(R & 31)) : R;
        voffA[i] = (unsigned)(R * g.lda + C) * 2u; voffB[i] = (unsigned)(Rb * g.ldb + C) * 2u; }
    const size_t kstep = (size_t)(BK * 2);
    const size_t hstepA = (size_t)HALF * g.lda * 2, hstepB = (size_t)HALF * g.ldb * 2;
    const size_t tstepA = 2 * hstepA, tstepB = 2 * hstepB;
    const unsigned ldsw = (unsigned)wid * 1024u;
    const int aoff = lds_byte(wr * 64 + fr, fq * 8), boff = lds_byte(wc * 32 + fr, fq * 8);
#define PG8_SA(b, h) (((b) * 2 + (h)) * HTB)
#define PG8_SB(b, h) ((4 + (b) * 2 + (h)) * HTB)
#define PG8_STAGE(bufoff, gbase, voff) do { _Pragma("unroll") for (int _i = 0; _i < 2; ++_i) \
        __builtin_amdgcn_global_load_lds((const unsigned*)((const char*)(gbase) + (voff)[_i]), (PG8_LAS unsigned*)(lds + (bufoff) + ldsw + _i * 8192), 16, 0, 0); } while (0)
#define PG8_LDA(dst, b, h) do { _Pragma("unroll") for (int m = 0; m < 4; ++m) _Pragma("unroll") for (int k = 0; k < 2; ++k) dst[m][k] = *(const PG8_LAS bf16x8*)(lds + PG8_SA(b, h) + aoff + m * 2048 + k * 1024); } while (0)
#define PG8_LDB(dst, b, h) do { _Pragma("unroll") for (int n = 0; n < 2; ++n) _Pragma("unroll") for (int k = 0; k < 2; ++k) dst[n][k] = *(const PG8_LAS bf16x8*)(lds + PG8_SB(b, h) + boff + n * 2048 + k * 1024); } while (0)
#define PG8_MMA(ai, bj, At, Bt) do { __builtin_amdgcn_s_setprio(1); _Pragma("unroll") for (int m = 0; m < 4; ++m) _Pragma("unroll") for (int n = 0; n < 2; ++n) _Pragma("unroll") for (int k = 0; k < 2; ++k) \
        acc[ai][bj][m][n] = __builtin_amdgcn_mfma_f32_16x16x32_bf16(Bt[n][k], At[m][k], acc[ai][bj][m][n], 0, 0, 0); __builtin_amdgcn_s_setprio(0); } while (0)
#define PG8_WAIT_V(n) asm volatile("s_waitcnt vmcnt(" #n ")" ::: "memory")
#define PG8_WAIT_L(n) asm volatile("s_waitcnt lgkmcnt(" #n ")" ::: "memory")
#define PG8_BAR __builtin_amdgcn_s_barrier()
#define PG8_SCHED __builtin_amdgcn_sched_barrier(0)
    Unit cur, nxt; int ui = 0;
    if (!S.next(0, cur)) return;
    f32x4 acc[2][2][4][2];
#pragma unroll
    for (int a = 0; a < 2; ++a)
#pragma unroll
        for (int b = 0; b < 2; ++b)
#pragma unroll
            for (int m = 0; m < 4; ++m)
#pragma unroll
                for (int n = 0; n < 2; ++n) acc[a][b][m][n] = (f32x4){0.f, 0.f, 0.f, 0.f};
    bf16x8 At[4][2], B0[2][2], B1[2][2];
    const char* cA = (const char*)g.A + (size_t)cur.pm * tstepA; const char* cB = (const char*)g.Bt + (size_t)cur.pn * tstepB;
    PG8_STAGE(PG8_SB(0, 0), cB, voffB); PG8_STAGE(PG8_SB(0, 1), cB + hstepB, voffB); PG8_STAGE(PG8_SA(0, 0), cA, voffA); PG8_STAGE(PG8_SA(0, 1), cA + hstepA, voffA);
    if (wr == 1) PG8_BAR;
    PG8_WAIT_V(2); PG8_BAR;
    PG8_STAGE(PG8_SB(1, 0), cB + kstep, voffB); PG8_STAGE(PG8_SA(1, 0), cA + kstep, voffA); PG8_STAGE(PG8_SB(1, 1), cB + hstepB + kstep, voffB);
    PG8_WAIT_V(6); PG8_BAR;
    for (;;) {
        const bool has_next = S.next(ui + 1, nxt);
        const char* nA = has_next ? (const char*)g.A + (size_t)nxt.pm * tstepA : cA; const char* nB = has_next ? (const char*)g.Bt + (size_t)nxt.pn * tstepB : cB;
        for (int t = 0; t < nt; t += 2) {
            const bool last = (t == nt - 2);
            const char* a1 = cA + (size_t)(t + 1) * kstep;
            const char* a2 = last ? nA : cA + (size_t)(t + 2) * kstep; const char* b2 = last ? nB : cB + (size_t)(t + 2) * kstep;
            const char* a3 = a2 + kstep; const char* b3 = b2 + kstep;
            if constexpr (Epi::KHOOK) E.khook(acc, cur, t, wr, wc, fr, fq);
            PG8_LDB(B0, 0, 0); PG8_LDB(B1, 0, 1); PG8_SCHED; PG8_LDA(At, 0, 0); PG8_STAGE(PG8_SA(1, 1), a1 + hstepA, voffA);
            PG8_WAIT_V(8); PG8_WAIT_L(0); PG8_BAR; PG8_MMA(0, 0, At, B0); PG8_MMA(0, 1, At, B1); PG8_BAR; PG8_SCHED;
            PG8_LDA(At, 0, 1); PG8_STAGE(PG8_SB(0, 0), b2, voffB); PG8_STAGE(PG8_SB(0, 1), b2 + hstepB, voffB); PG8_STAGE(PG8_SA(0, 0), a2, voffA);
            PG8_WAIT_V(8); PG8_WAIT_L(0); PG8_BAR; PG8_MMA(1, 0, At, B0); PG8_MMA(1, 1, At, B1); PG8_BAR; PG8_SCHED;
            PG8_LDB(B0, 1, 0); PG8_LDB(B1, 1, 1); PG8_SCHED; PG8_LDA(At, 1, 0); PG8_STAGE(PG8_SA(0, 1), a2 + hstepA, voffA);
            PG8_WAIT_V(8); PG8_WAIT_L(0); PG8_BAR; PG8_MMA(0, 0, At, B0); PG8_MMA(0, 1, At, B1); PG8_BAR; PG8_SCHED;
            PG8_LDA(At, 1, 1); PG8_STAGE(PG8_SB(1, 0), b3, voffB); PG8_STAGE(PG8_SB(1, 1), b3 + hstepB, voffB); PG8_STAGE(PG8_SA(1, 0), a3, voffA);
            PG8_WAIT_V(8); PG8_WAIT_L(0); PG8_BAR; PG8_MMA(1, 0, At, B0); PG8_MMA(1, 1, At, B1); PG8_BAR; PG8_SCHED;
        }
        if constexpr (ALIGN_EPI) { if (wr == 0) PG8_BAR; }
        E(acc, cur, wr, wc, fr, fq);
        if (!has_next) break;
#pragma unroll
        for (int a = 0; a < 2; ++a)
#pragma unroll
            for (int b = 0; b < 2; ++b)
#pragma unroll
                for (int m = 0; m < 4; ++m)
#pragma unroll
                    for (int n = 0; n < 2; ++n) acc[a][b][m][n] = (f32x4){0.f, 0.f, 0.f, 0.f};
        cur = nxt; cA = nA; cB = nB; ++ui;
        if constexpr (ALIGN_EPI) { if (wr == 1) PG8_BAR; }
    }
    PG8_WAIT_V(0);
    if constexpr (!ALIGN_EPI) { if (wr == 0) PG8_BAR; }
    PG8_BAR;
#undef PG8_SA
#undef PG8_SB
#undef PG8_STAGE
#undef PG8_LDA
#undef PG8_LDB
#undef PG8_MMA
#undef PG8_WAIT_V
#undef PG8_WAIT_L
#undef PG8_BAR
#undef PG8_SCHED
}
}

constexpr int NWAVES = 8;
constexpr int DM = 1024, MP = 16384, MS = 512, MT = MP + MS;
constexpr int SEQ = 2048, DSEQ = 64, DEPTH = 2, NB = 8;
constexpr int D_IN = 8720;
constexpr int ZP = 5632;
constexpr int CA = 0, CU = 512, CVB = 1024, CQ = 1536, CK = 2048, CGC = 2560, CGA = 3584, CGB = 4096, CVC = 4608, CY = 3584;
constexpr int N1A = 5632, N1B = 3072, N1 = N1A + N1B;
constexpr float EPS = 1e-6f;
constexpr size_t O_YP = 0, O_YS = 16777216, O_PP = 17301504, O_GP = 17424384, O_PS = 19521536, O_GS = 19644416, O_SV = 21741568, O_END = 22265856;

constexpr size_t MiB = 1u << 20;
constexpr size_t WS_CTL = 0, CTL_ZERO_BYTES = 64 * 1024;
constexpr size_t WS_MOD = 1 * MiB;
constexpr size_t WS_ZLR = 2 * MiB;
constexpr size_t WS_WLR = 3 * MiB + 512 * 1024;
constexpr size_t WS_W1 = 4 * MiB;
constexpr size_t WS_WCAT = 38 * MiB;
constexpr size_t WS_WOUT = 46 * MiB;
constexpr size_t WS_XN = 50 * MiB;
constexpr size_t WS_Z = 83 * MiB;
constexpr size_t WS_END = WS_Z + (size_t)MT * ZP * 2;
static_assert(WS_ZLR + (size_t)MT * 16 * 4 <= WS_WLR && WS_W1 + (size_t)2 * N1 * 1024 * 2 <= WS_WCAT && WS_WCAT + (size_t)2 * 1024 * 2048 * 2 <= WS_WOUT && WS_WOUT + (size_t)2 * 1024 * 1024 * 2 <= WS_XN && WS_XN + (size_t)MT * 1024 * 2 <= WS_Z, "ws map");
constexpr int CW_TMO = 0, CW_BAR = 4096;

constexpr int RING_BYTES = 131072, LDSCTL_OFF = RING_BYTES, MISC_OFF = LDSCTL_OFF + 320, LDS_BYTES = 147456;

#define GAS __attribute__((address_space(1)))
#define LAS __attribute__((address_space(3)))
typedef unsigned short bf16;
typedef unsigned v4u __attribute__((ext_vector_type(4)));
typedef unsigned v2u __attribute__((ext_vector_type(2)));
typedef float f32x4 __attribute__((ext_vector_type(4)));
typedef GAS unsigned gu32;
#define RLX_AGENT __ATOMIC_RELAXED, __HIP_MEMORY_SCOPE_AGENT
#define LDS_WAIT() asm volatile("s_waitcnt lgkmcnt(0)" ::: "memory")
__device__ __forceinline__ unsigned f2bf(float f) { unsigned u = __builtin_bit_cast(unsigned, f); return (u + 0x7fffu + ((u >> 16) & 1u)) >> 16; }
__device__ __forceinline__ unsigned pk2(float lo, float hi) { return f2bf(lo) | (f2bf(hi) << 16); }
__device__ __forceinline__ float bf2f(bf16 v) { return __uint_as_float((unsigned)v << 16); }
__device__ __forceinline__ float siluf_(float x) { return x * __builtin_amdgcn_rcpf(1.0f + __expf(-x)); }

#define XB_TMO      128
#define XB_XCNT(j)  (256  + 64 * (j))
#define XB_XSUB(j)  (1280 + 64 * (j))
#define XB_XGEN(j)  (2304 + 64 * (j))
#define XB_TOP      3328
#define XB_TOPGEN   3392
#define XCD_BAR_WORDS 3456
#define XB_SPIN_CAP (1u << 18)
__device__ __forceinline__ unsigned xb_ld(unsigned* p)              { return __hip_atomic_load(p, __ATOMIC_RELAXED, __HIP_MEMORY_SCOPE_AGENT); }
__device__ __forceinline__ unsigned xb_add(unsigned* p, unsigned v) { return __hip_atomic_fetch_add(p, v, __ATOMIC_RELAXED, __HIP_MEMORY_SCOPE_AGENT); }
__device__ __forceinline__ unsigned xb_xcc_id() { return (unsigned)__builtin_amdgcn_s_getreg((3 << 11) | 20) & 0xFu; }
#define XB_SPIN(cond, bar) do { unsigned _sp = 0; while (cond) { __builtin_amdgcn_s_sleep(1); \
    if ((++_sp & 255u) == 0u) { if (xb_ld(&(bar)[XB_TMO])) break; if (_sp > XB_SPIN_CAP) { atomicAdd(&(bar)[XB_TMO], 1u); break; } } } } while (0)
struct XcdBarrier { unsigned* bar; unsigned x; volatile LAS unsigned* st; };
__device__ __forceinline__ XcdBarrier xcd_barrier_post(unsigned* bar, volatile LAS unsigned* st) {
    XcdBarrier b; b.bar = bar; b.x = xb_xcc_id(); b.st = st;
    if (threadIdx.x == 0) (void)xb_add(&bar[XB_XCNT(b.x)], 1u);
    return b;
}
__device__ __forceinline__ void xcd_barrier_complete(unsigned* bar, unsigned x, unsigned& nloc, unsigned& nx) {
    const unsigned G = gridDim.x * gridDim.y * gridDim.z;
    unsigned sum, cnt, mine, sp = 0u;
    for (;;) {
        sum = 0u; cnt = 0u; mine = 0u;
#pragma unroll
        for (unsigned j = 0; j < 16; ++j) { const unsigned c = xb_ld(&bar[XB_XCNT(j)]); sum += c; cnt += (c > 0u) ? 1u : 0u; mine = (j == x) ? c : mine; }
        if (sum == G) break;
        __builtin_amdgcn_s_sleep(1);
        if ((++sp & 255u) == 0u) { if (xb_ld(&bar[XB_TMO])) break; if (sp > XB_SPIN_CAP) { atomicAdd(&bar[XB_TMO], 1u); break; } }
    }
    nloc = mine > 0u ? mine : 1u; nx = cnt > 0u ? cnt : 1u;
}
__device__ __forceinline__ void xcd_barrier(const XcdBarrier& b) {
    asm volatile("s_waitcnt vmcnt(0)" ::: "memory");
    __syncthreads();
    if (threadIdx.x == 0) {
        unsigned* bar = b.bar;
        __builtin_amdgcn_s_waitcnt(0);
        unsigned nloc = b.st[0], nx = b.st[1];
        if (nloc == 0u) { xcd_barrier_complete(bar, b.x, nloc, nx); b.st[0] = nloc; b.st[1] = nx; }
        const unsigned old = xb_add(&bar[XB_XSUB(b.x)], 1u);
        const unsigned gen = old / nloc;
        if (old + 1u == (gen + 1u) * nloc) {
            __builtin_amdgcn_fence(__ATOMIC_RELEASE, "agent");
            asm volatile("s_waitcnt vmcnt(0)" ::: "memory");
            const unsigned og = xb_add(&bar[XB_TOP], 1u);
            const unsigned tg = og / nx;
            if (og + 1u == (tg + 1u) * nx) xb_add(&bar[XB_TOPGEN], 1u);
            else XB_SPIN(xb_ld(&bar[XB_TOPGEN]) == tg, bar);
            __builtin_amdgcn_fence(__ATOMIC_ACQUIRE, "agent");
            xb_add(&bar[XB_XGEN(b.x)], 1u);
            asm volatile("s_waitcnt vmcnt(0)" ::: "memory");
        } else {
            XB_SPIN(xb_ld(&bar[XB_XGEN(b.x)]) == gen, bar);
            __builtin_amdgcn_fence(__ATOMIC_ACQUIRE, "agent");
            asm volatile("s_waitcnt vmcnt(0)" ::: "memory");
        }
    }
    __syncthreads();
}

__device__ __forceinline__ int opq(int x) { asm volatile("" : "+v"(x)); return x; }
struct Frame {
    LAS unsigned char* lds;
    int tid, lane, wave, vcu, G;
};
__device__ __forceinline__ float wave_sum(float v) {
    v += __int_as_float(__builtin_amdgcn_ds_swizzle(__float_as_int(v), 0x041F));
    v += __int_as_float(__builtin_amdgcn_ds_swizzle(__float_as_int(v), 0x081F));
    v += __int_as_float(__builtin_amdgcn_ds_swizzle(__float_as_int(v), 0x101F));
    v += __int_as_float(__builtin_amdgcn_ds_swizzle(__float_as_int(v), 0x201F));
    v += __int_as_float(__builtin_amdgcn_ds_swizzle(__float_as_int(v), 0x401F));
    const auto rr = __builtin_amdgcn_permlane32_swap(__float_as_uint(v), __float_as_uint(v), false, false);
    return __uint_as_float(rr[0]) + __uint_as_float(rr[1]);
}
enum { I_XP = 0, I_XS, I_SPOOL, I_SGLA, I_CP, I_CS, I_ADAW, I_ADAB, I_PREG, I_POSTG, I_WIN, I_POOLW, I_POOLS, I_SGUG, I_SGUW, I_SGUB, I_WA2, I_BA, I_GLAG, I_WOA, I_WOB, I_WOC, I_WOUT, N_IN };
struct Args { const float* in[N_IN]; float* out; unsigned char* ws; int ph_lo, ph_hi, li, pad; };

__device__ __forceinline__ void transpose_item(const float* src, int ldsrc, bf16* dst, int ldd, LAS float* scr, int lane) {
#pragma unroll 8
    for (int i = 0; i < 32; ++i) { const int kk = 2 * i + (lane >> 5); scr[kk * 33 + (lane & 31)] = src[(size_t)kk * ldsrc + (lane & 31)]; }
    LDS_WAIT(); asm volatile("" ::: "memory");
    const int c = lane & 7;
#pragma unroll
    for (int j = 0; j < 4; ++j) { const int n = (lane >> 3) + 8 * j; const LAS float* s = scr + (8 * c) * 33 + n;
        v4u o; o.x = pk2(s[0 * 33], s[1 * 33]); o.y = pk2(s[2 * 33], s[3 * 33]); o.z = pk2(s[4 * 33], s[5 * 33]); o.w = pk2(s[6 * 33], s[7 * 33]);
        *(GAS v4u*)(dst + (size_t)n * ldd + 8 * c) = o; }
    LDS_WAIT(); asm volatile("" ::: "memory");
}
__device__ __forceinline__ int w1_src_col(int n) {
    if (n < 512) return n;
    if (n < 1024) return 1024 + (n - 512);
    if (n < 1536) return 1536 + (n - 1024);
    if (n < 2048) return 2560 + (n - 1536);
    if (n < 2560) return 3072 + (n - 2048);
    if (n < 3584) return 4608 + (n - 2560);
    if (n < 4096) return 512 + (n - 3584);
    if (n < 4608) return 2048 + (n - 4096);
    if (n < 5632) return 3584 + (n - 4608);
    return 5648 + (n - 5632);
}
__device__ __forceinline__ int batch_of_row(int m) { return m < MP ? (m >> 11) : 8 + ((m - MP) >> 6); }

__device__ __forceinline__ void xn_row(const float* xrow, const float* g, const float* mod  , bf16* orow, int lane) {
    const GAS f32x4* xr = (const GAS f32x4*)xrow + lane;
    f32x4 v[4]; float s = 0.f;
#pragma unroll
    for (int j = 0; j < 4; ++j) { v[j] = xr[64 * j]; s += (v[j].x * v[j].x + v[j].y * v[j].y) + (v[j].z * v[j].z + v[j].w * v[j].w); }
    const float rstd = 1.0f / sqrtf(wave_sum(s) * (1.f / DM) + EPS);
    GAS unsigned long long* o8 = (GAS unsigned long long*)orow + lane;
#pragma unroll
    for (int j = 0; j < 4; ++j) {
        const int c = 4 * lane + 256 * j;
        const f32x4 gg = *(const f32x4*)(g + c), sh = *(const f32x4*)(mod + c), sc = *(const f32x4*)(mod + 1024 + c);
        const f32x4 h = (v[j] * rstd) * gg * (sc + 1.0f) + sh;
        o8[64 * j] = (unsigned long long)pk2(h.x, h.y) | ((unsigned long long)pk2(h.z, h.w) << 32);
    }
}

constexpr int NPH = 16;

__global__ void __launch_bounds__(NWAVES * 64, 2) mk_fwd(Args args) {
    extern __shared__ __attribute__((aligned(16))) unsigned char lds[];
    Frame F;
    F.lds = (LAS unsigned char*)lds;
    volatile LAS unsigned* MISC = (volatile LAS unsigned*)(F.lds + MISC_OFF);
    F.tid = threadIdx.x; F.lane = F.tid & 63; F.wave = __builtin_amdgcn_readfirstlane(F.tid >> 6);
    F.G = gridDim.x; { const int bx = blockIdx.x; F.vcu = (F.G % 8 == 0) ? (bx % 8) * (F.G / 8) + bx / 8 : bx; }
    unsigned char* ws = args.ws;
    gu32* ctl = (gu32*)(ws + WS_CTL);
    for (int u = F.tid; u < (LDS_BYTES - LDSCTL_OFF) / 4; u += NWAVES * 64) ((LAS unsigned*)(F.lds + LDSCTL_OFF))[u] = 0u;
    __syncthreads();
    XcdBarrier bar; bar.bar = (unsigned*)(ctl + CW_BAR); bar.x = 0; bar.st = nullptr;
    if (MK_N_LAUNCHES == 1) bar = xcd_barrier_post((unsigned*)(ctl + CW_BAR), MISC + 8);
#define GRID_BAR() do { if (MK_N_LAUNCHES == 1) xcd_barrier(bar); } while (0)
    const int lo = args.ph_lo, hi = args.ph_hi;
#ifndef ABLMASK
#define ABLMASK 0xffff
#endif
#define IN(k) (lo <= (k) && (k) < hi)
#define PHASE_BEGIN() do { F.tid = opq((int)threadIdx.x); F.lane = F.tid & 63; } while (0)
#define KON(b) ((ABLMASK >> (b)) & 1)
    float* mod_all = (float*)(ws + WS_MOD);
    float* zlr = (float*)(ws + WS_ZLR);
    float* wlr_all = (float*)(ws + WS_WLR);
    bf16* XN = (bf16*)(ws + WS_XN);
    bf16* Z = (bf16*)(ws + WS_Z);
    float* OUTF = (float*)(ws + WS_Z);
    float* dout = args.out;
    const int gw = F.vcu * NWAVES + F.wave, NGW = F.G * NWAVES;

    if (KON(0) && IN(0)) {
        PHASE_BEGIN();
        LAS float* scr = (LAS float*)(F.lds + F.wave * 16384);
        constexpr int I_W1 = (1024 / 64) * (N1 / 32);
        constexpr int I_OA = (512 / 64) * 32, I_OC = (1024 / 64) * 32, I_OUT = (1024 / 64) * 32;
        constexpr int PER_L = I_W1 + 2 * I_OA + I_OC + I_OUT;
        for (int it = gw; it < 2 * PER_L; it += NGW) {
            const int l = it / PER_L; int r = it % PER_L;
            if (r < I_W1) { const int nb = r % (N1 / 32), kb = r / (N1 / 32); const int n0 = 32 * nb, k0 = 64 * kb;
                transpose_item(args.in[I_WIN] + (size_t)l * 1024 * D_IN + (size_t)k0 * D_IN + w1_src_col(n0), D_IN, (bf16*)(ws + WS_W1) + ((size_t)l * N1 + n0) * 1024 + k0, 1024, scr, F.lane); continue; }
            r -= I_W1;
            bf16* wcat = (bf16*)(ws + WS_WCAT) + (size_t)l * 1024 * 2048;
            if (r < I_OA) { const int nb = r % 32, kb = r / 32; transpose_item(args.in[I_WOA] + (size_t)l * 512 * 1024 + (size_t)(64 * kb) * 1024 + 32 * nb, 1024, wcat + (size_t)(32 * nb) * 2048 + 64 * kb, 2048, scr, F.lane); continue; }
            r -= I_OA;
            if (r < I_OA) { const int nb = r % 32, kb = r / 32; transpose_item(args.in[I_WOB] + (size_t)l * 512 * 1024 + (size_t)(64 * kb) * 1024 + 32 * nb, 1024, wcat + (size_t)(32 * nb) * 2048 + 512 + 64 * kb, 2048, scr, F.lane); continue; }
            r -= I_OA;
            if (r < I_OC) { const int nb = r % 32, kb = r / 32; transpose_item(args.in[I_WOC] + (size_t)l * 1024 * 1024 + (size_t)(64 * kb) * 1024 + 32 * nb, 1024, wcat + (size_t)(32 * nb) * 2048 + 1024 + 64 * kb, 2048, scr, F.lane); continue; }
            r -= I_OC;
            { const int nb = r % 32, kb = r / 32; transpose_item(args.in[I_WOUT] + (size_t)l * 1024 * 1024 + (size_t)(64 * kb) * 1024 + 32 * nb, 1024, (bf16*)(ws + WS_WOUT) + (size_t)l * 1024 * 1024 + (size_t)(32 * nb) * 1024 + 64 * kb, 1024, scr, F.lane); }
        }
        for (int i = blockIdx.x * 512 + F.tid; i < 2 * 16 * 1024; i += F.G * 512) { const int l = i >> 14, r = (i >> 10) & 15, k = i & 1023; wlr_all[i] = args.in[I_WIN][(size_t)l * 1024 * D_IN + (size_t)k * D_IN + 5632 + r]; }
        __syncthreads();
        LAS float* sc = (LAS float*)F.lds;
        LAS float* part = (LAS float*)(F.lds + 65536);
        for (int it = F.vcu; it < 2 * 48; it += F.G) {
            const int l = it / 48, j0 = (it % 48) * 64;
            for (int i = F.tid; i < 16 * 1024; i += 512) { const int bi = i >> 10, k = i & 1023; const float cv = bi < 8 ? args.in[I_CP][bi * 1024 + k] : args.in[I_CS][(bi - 8) * 1024 + k]; sc[i] = siluf_(cv); }
            __syncthreads();
            float a[16];
#pragma unroll
            for (int b = 0; b < 16; ++b) a[b] = 0.f;
            const float* wp = args.in[I_ADAW] + (size_t)l * 1024 * 3072 + j0 + F.lane;
            for (int k = F.wave * 128; k < F.wave * 128 + 128; ++k) {
                const float w = wp[(size_t)k * 3072];
#pragma unroll
                for (int b = 0; b < 16; ++b) a[b] += sc[b * 1024 + k] * w;
            }
#pragma unroll
            for (int b = 0; b < 16; ++b) part[(F.wave * 16 + b) * 64 + F.lane] = a[b];
            __syncthreads();
            for (int i = F.tid; i < 16 * 64; i += 512) { const int b = i >> 6, j = i & 63; float s = 0.f;
#pragma unroll
                for (int w = 0; w < 8; ++w) s += part[(w * 16 + b) * 64 + j];
                mod_all[((size_t)l * 16 + b) * 3072 + j0 + j] = s + args.in[I_ADAB][l * 3072 + j0 + j]; }
            __syncthreads();
        }
        GRID_BAR();
    }
    if (KON(1) && IN(1)) {
        PHASE_BEGIN();
        for (int m = gw; m < MT; m += NGW) {
            const float* xrow = m < MP ? args.in[I_XP] + (size_t)m * DM : args.in[I_XS] + (size_t)(m - MP) * DM;
            xn_row(xrow, args.in[I_PREG], mod_all + (size_t)batch_of_row(m) * 3072, XN + (size_t)m * DM, F.lane);
        }
        GRID_BAR();
    }
    for (int l = 0; l < DEPTH; ++l) {
        const int pb = 2 + 7 * l;
        const float* mod_l = mod_all + (size_t)l * 16 * 3072;
        const bf16* W1 = (const bf16*)(ws + WS_W1) + (size_t)l * N1 * 1024;
        if (KON(2) && IN(pb + 0)) {
        PHASE_BEGIN();
            const float* wl = wlr_all + (size_t)l * 16 * 1024;
            for (int m = gw; m < MT; m += NGW) {
                const GAS v4u* xr = (const GAS v4u*)(XN + (size_t)m * DM) + F.lane * 2;
                const v4u x0 = xr[0], x1 = xr[1];
                float xv[16];
                xv[0] = pg8::bflo(x0.x); xv[1] = pg8::bfhi(x0.x); xv[2] = pg8::bflo(x0.y); xv[3] = pg8::bfhi(x0.y); xv[4] = pg8::bflo(x0.z); xv[5] = pg8::bfhi(x0.z); xv[6] = pg8::bflo(x0.w); xv[7] = pg8::bfhi(x0.w);
                xv[8] = pg8::bflo(x1.x); xv[9] = pg8::bfhi(x1.x); xv[10] = pg8::bflo(x1.y); xv[11] = pg8::bfhi(x1.y); xv[12] = pg8::bflo(x1.z); xv[13] = pg8::bfhi(x1.z); xv[14] = pg8::bflo(x1.w); xv[15] = pg8::bfhi(x1.w);
                float myv = 0.f;
                for (int r = 0; r < 16; ++r) {
                    const float* wr_ = wl + r * 1024 + 16 * F.lane; float s = 0.f;
#pragma unroll
                    for (int j = 0; j < 16; ++j) s += xv[j] * wr_[j];
                    s = wave_sum(s);
                    if (F.lane == r) myv = s;
                }
                if (F.lane < 16) zlr[(size_t)m * 16 + F.lane] = myv;
            }
            __syncthreads();
            pg8::Gemm g{XN, W1, 1024, 1024, 1024}; pg8::StaticOrder S; S.init(MT / 256, N1A / 256, F.G, (int)blockIdx.x);
            pg8::EpiZ E{Z, ZP, dout + O_PP + (size_t)l * NB * 15 * 512, dout + O_PS + (size_t)l * NB * 15 * 512};
            pg8::gemm_phase<pg8::EpiZ, pg8::StaticOrder, true>(F.lds, g, S, E);
            GRID_BAR();
        }
        if (KON(3) && IN(pb + 1)) {
        PHASE_BEGIN();
            {
                LAS float* at = (LAS float*)F.lds;
                LAS float* dt = (LAS float*)(F.lds + 79 * 128 * 4);
                const float* pw = args.in[I_POOLW] + (size_t)l * 4 * 128 * 128;
                for (int it = F.vcu; it < (MT / 64) * 4; it += F.G) {
                    const int tile = it >> 2, g = it & 3, w = 2 << g;
                    const int m0 = tile * 64; const bool smp = m0 >= MP;
                    const int bb = smp ? ((m0 - MP) >> 6) : (m0 >> 11), t0 = smp ? 0 : (m0 & 2047), pos0 = smp ? SEQ : 0;
                    for (int i = F.tid; i < 79 * 128; i += 512) {
                        const int ri = i >> 7, c = i & 127, t = t0 - 15 + ri; float v;
                        if (t >= 0) v = bf2f(Z[(size_t)(m0 - 15 + ri) * ZP + CA + g * 128 + c]);
                        else v = smp ? args.in[I_SPOOL][(((size_t)l * NB + bb) * 15 + (15 + t)) * 512 + g * 128 + c] : 0.f;
                        at[i] = v;
                    }
                    __syncthreads();
                    for (int i = F.tid; i < 64 * 128; i += 512) {
                        const int tt = i >> 7, c = i & 127; float s = 0.f;
                        for (int k = 0; k < w; ++k) s += at[(tt + 15 - k) * 128 + c];
                        const int pos = pos0 + t0 + tt; const float cnt = (float)((pos + 1) < w ? (pos + 1) : w);
                        dt[i] = s / cnt - at[(tt + 15) * 128 + c];
                    }
                    __syncthreads();
                    {
                        const int cp = F.tid & 127, tq = F.tid >> 7;
                        float acc[16];
#pragma unroll
                        for (int j = 0; j < 16; ++j) acc[j] = 0.f;
                        for (int c = 0; c < 128; ++c) {
                            const float wv = pw[((size_t)g * 128 + c) * 128 + cp];
#pragma unroll
                            for (int j = 0; j < 16; ++j) acc[j] += dt[(tq * 16 + j) * 128 + c] * wv;
                        }
                        const float psc = args.in[I_POOLS][l * 512 + g * 128 + cp];
#pragma unroll
                        for (int j = 0; j < 16; ++j) {
                            bf16* p = Z + (size_t)(m0 + tq * 16 + j) * ZP + CGA + g * 128 + cp;
                            const float ga = bf2f(*p);
                            *p = (bf16)f2bf(acc[j] * psc * siluf_(ga));
                        }
                    }
                    __syncthreads();
                }
            }
            {
                LAS float* vn = (LAS float*)F.lds;
                const float* sw = args.in[I_SGUW] + (size_t)l * 4 * 128 * 128;
                for (int it = F.vcu; it < 136 * 4; it += F.G) {
                    const int ch = it >> 2, g = it & 3;
                    const bool smp = ch >= 128; const int L = smp ? 64 : 128, m0 = smp ? MP + (ch - 128) * 64 : ch * 128;
                    for (int j = F.wave; j < L; j += 8) {
                        const v4u raw = *(const GAS v4u*)(Z + (size_t)(m0 + j) * ZP + CVB + 8 * F.lane);
                        float x[8]; x[0] = pg8::bflo(raw.x); x[1] = pg8::bfhi(raw.x); x[2] = pg8::bflo(raw.y); x[3] = pg8::bfhi(raw.y); x[4] = pg8::bflo(raw.z); x[5] = pg8::bfhi(raw.z); x[6] = pg8::bflo(raw.w); x[7] = pg8::bfhi(raw.w);
                        float s = 0.f;
#pragma unroll
                        for (int e = 0; e < 8; ++e) s += x[e];
                        const float mu = wave_sum(s) * (1.f / 512.f); float q = 0.f;
#pragma unroll
                        for (int e = 0; e < 8; ++e) { x[e] -= mu; q += x[e] * x[e]; }
                        const float rstd = 1.0f / sqrtf(wave_sum(q) * (1.f / 512.f) + EPS);
                        if ((F.lane >> 4) == g) {
                            const int c0 = 8 * (F.lane & 15);
#pragma unroll
                            for (int e = 0; e < 8; ++e) {
                                const float y = x[e] * rstd * args.in[I_SGUG][l * 512 + g * 128 + c0 + e];
                                vn[j * 128 + c0 + e] = y;
                                if (smp) dout[O_SV + (((size_t)l * NB + (ch - 128)) * 64 + j) * 512 + g * 128 + c0 + e] = y;
                            }
                        }
                    }
                    __syncthreads();
                    {
                        const int c = F.tid & 127, iq = F.tid >> 7;
                        for (int i = iq; i < L; i += 4) {
                            float s = args.in[I_SGUB][(l * 4 + g) * 128 + i];
                            const float* wrow = sw + ((size_t)g * 128 + i) * 128;
                            for (int j = 0; j <= i; ++j) s += wrow[j] * vn[j * 128 + c];
                            const size_t rb = (size_t)(m0 + i) * ZP;
                            const float u = bf2f(Z[rb + CU + g * 128 + c]), gb = bf2f(Z[rb + CGB + g * 128 + c]);
                            Z[rb + CGB + g * 128 + c] = (bf16)f2bf(u * s * siluf_(gb));
                        }
                    }
                    __syncthreads();
                }
            }
            {
                LAS float* dec = (LAS float*)F.lds;
                LAS float* qs = dec + 16 * 128;
                LAS float* ks = qs + 16 * 128;
                for (int it = F.vcu; it < 64; it += F.G) {
                    const bool smp = it >= 32; const int bh = it & 31, bb = bh >> 2, h = bh & 3;
                    const int T = smp ? DSEQ : SEQ, m0 = smp ? MP + bb * 64 : bb * SEQ;
                    float S[128];
                    const int dv = F.tid & 255;
                    if (smp) {
                        const float* s0 = args.in[I_SGLA] + (((size_t)l * NB + bb) * 4 + h) * 128 * 256 + dv;
#pragma unroll
                        for (int d = 0; d < 128; ++d) S[d] = s0[(size_t)d * 256];
                    } else {
#pragma unroll
                        for (int d = 0; d < 128; ++d) S[d] = 0.f;
                    }
                    for (int tc = 0; tc < T; tc += 16) {
                        for (int i = F.tid; i < 16 * 128; i += 512) {
                            const int tt = i >> 7, d = i & 127; const size_t m = (size_t)(m0 + tc + tt);
                            float x = args.in[I_BA][l * 512 + h * 128 + d];
                            const float* zr = zlr + m * 16; const float* w2 = args.in[I_WA2] + (size_t)l * 16 * 512 + h * 128 + d;
#pragma unroll
                            for (int r = 0; r < 16; ++r) x += zr[r] * w2[r * 512];
                            const float ls = fminf(x, 0.f) - log1pf(__expf(-fabsf(x)));
                            dec[i] = __expf(ls * (1.0f / 16.0f));
                            qs[i] = bf2f(Z[m * ZP + CQ + h * 128 + d]) * 0.08838834764831845f;
                            ks[i] = bf2f(Z[m * ZP + CK + h * 128 + d]);
                        }
                        __syncthreads();
                        if (F.tid < 256) {
                            for (int tt = 0; tt < 16; ++tt) {
                                bf16* vp = Z + (size_t)(m0 + tc + tt) * ZP + CVC + h * 256 + dv;
                                const float v = bf2f(*vp); float o = 0.f;
#pragma unroll
                                for (int d = 0; d < 128; ++d) { S[d] = dec[tt * 128 + d] * S[d] + ks[tt * 128 + d] * v; o += qs[tt * 128 + d] * S[d]; }
                                *vp = (bf16)f2bf(o);
                            }
                        }
                        __syncthreads();
                    }
                    if (F.tid < 256) {
                        float* so = dout + (smp ? O_GS : O_GP) + (((size_t)l * NB + bb) * 4 + h) * 128 * 256 + dv;
#pragma unroll
                        for (int d = 0; d < 128; ++d) so[(size_t)d * 256] = S[d];
                    }
                }
            }
            GRID_BAR();
        }
        if (KON(4) && IN(pb + 2)) {
        PHASE_BEGIN();
            for (int it = gw; it < MT * 4; it += NGW) {
                const int m = it >> 2, h = it & 3;
                bf16* op = Z + (size_t)m * ZP + CVC + h * 256 + 4 * F.lane;
                const v2u raw = *(const GAS v2u*)op; const v2u graw = *(const GAS v2u*)(Z + (size_t)m * ZP + CGC + h * 256 + 4 * F.lane);
                float o[4] = {pg8::bflo(raw.x), pg8::bfhi(raw.x), pg8::bflo(raw.y), pg8::bfhi(raw.y)};
                const float gc[4] = {pg8::bflo(graw.x), pg8::bfhi(graw.x), pg8::bflo(graw.y), pg8::bfhi(graw.y)};
                const float ss = wave_sum((o[0] * o[0] + o[1] * o[1]) + (o[2] * o[2] + o[3] * o[3]));
                const float rstd = 1.0f / sqrtf(ss * (1.f / 256.f) + EPS);
                const f32x4 gg = *(const f32x4*)(args.in[I_GLAG] + l * 256 + 4 * F.lane);
                v2u w; w.x = pk2(o[0] * rstd * gg.x * siluf_(gc[0]), o[1] * rstd * gg.y * siluf_(gc[1])); w.y = pk2(o[2] * rstd * gg.z * siluf_(gc[2]), o[3] * rstd * gg.w * siluf_(gc[3]));
                *(GAS v2u*)op = w;
            }
            GRID_BAR();
        }
        if (KON(5) && IN(pb + 3)) {
        PHASE_BEGIN();
            pg8::Gemm g{XN, W1 + (size_t)N1A * 1024, 1024, 1024, 1024}; pg8::StaticOrder S; S.init(MT / 256, N1B / 256, F.G, (int)blockIdx.x);
            pg8::EpiGm E{Z, ZP};
            pg8::gemm_phase<pg8::EpiGm, pg8::StaticOrder, true>(F.lds, g, S, E);
            GRID_BAR();
        }
        if (KON(6) && IN(pb + 4)) {
        PHASE_BEGIN();
            pg8::Gemm g{Z + CY, (const bf16*)(ws + WS_WCAT) + (size_t)l * 1024 * 2048, ZP, 2048, 2048}; pg8::StaticOrder S; S.init(MT / 256, 4, F.G, (int)blockIdx.x);
            pg8::EpiMerge E{Z, ZP, XN, 1024};
            pg8::gemm_phase<pg8::EpiMerge, pg8::StaticOrder, true>(F.lds, g, S, E);
            GRID_BAR();
        }
        if (KON(7) && IN(pb + 5)) {
        PHASE_BEGIN();
            pg8::Gemm g{XN, (const bf16*)(ws + WS_WOUT) + (size_t)l * 1024 * 1024, 1024, 1024, 1024}; pg8::StaticOrder S; S.init(MT / 256, 4, F.G, (int)blockIdx.x);
            pg8::EpiF32 E{OUTF, 1024};
            pg8::gemm_phase<pg8::EpiF32, pg8::StaticOrder, true>(F.lds, g, S, E);
            GRID_BAR();
        }
        if (KON(8) && IN(pb + 6)) {
        PHASE_BEGIN();
            for (int m = gw; m < MT; m += NGW) {
                const float* xprev = (l == 0) ? (m < MP ? args.in[I_XP] + (size_t)m * DM : args.in[I_XS] + (size_t)(m - MP) * DM) : dout + (size_t)m * DM;
                const GAS f32x4* orow = (const GAS f32x4*)(OUTF + (size_t)m * DM) + F.lane;
                const float* modb = mod_l + (size_t)batch_of_row(m) * 3072;
                f32x4 v[4]; float s = 0.f;
#pragma unroll
                for (int j = 0; j < 4; ++j) { v[j] = orow[64 * j]; s += (v[j].x * v[j].x + v[j].y * v[j].y) + (v[j].z * v[j].z + v[j].w * v[j].w); }
                const float rstd = 1.0f / sqrtf(wave_sum(s) * (1.f / DM) + EPS);
                float s2 = 0.f;
#pragma unroll
                for (int j = 0; j < 4; ++j) {
                    const int c = 4 * F.lane + 256 * j;
                    const f32x4 pg = *(const f32x4*)(args.in[I_POSTG] + l * 1024 + c), gt = *(const f32x4*)(modb + 2048 + c), xp = *(const f32x4*)(xprev + c);
                    v[j] = xp + gt * ((v[j] * rstd) * pg);
                    *(f32x4*)(dout + (size_t)m * DM + c) = v[j];
                    s2 += (v[j].x * v[j].x + v[j].y * v[j].y) + (v[j].z * v[j].z + v[j].w * v[j].w);
                }
                if (l + 1 < DEPTH) {
                    const float rstd2 = 1.0f / sqrtf(wave_sum(s2) * (1.f / DM) + EPS);
                    const float* modn = mod_all + ((size_t)(l + 1) * 16 + batch_of_row(m)) * 3072;
                    GAS unsigned long long* o8 = (GAS unsigned long long*)(XN + (size_t)m * DM) + F.lane;
#pragma unroll
                    for (int j = 0; j < 4; ++j) {
                        const int c = 4 * F.lane + 256 * j;
                        const f32x4 gg = *(const f32x4*)(args.in[I_PREG] + (l + 1) * 1024 + c), sh = *(const f32x4*)(modn + c), sc = *(const f32x4*)(modn + 1024 + c);
                        const f32x4 hh = (v[j] * rstd2) * gg * (sc + 1.0f) + sh;
                        o8[64 * j] = (unsigned long long)pk2(hh.x, hh.y) | ((unsigned long long)pk2(hh.z, hh.w) << 32);
                    }
                }
            }
            if (l + 1 < DEPTH) GRID_BAR();
        }
    }
#undef IN
#undef GRID_BAR
}

extern "C" void kernel_launch(void* const* d_in, const int* in_sizes, int n_in, void* d_out, int out_size, void* d_ws, size_t ws_size, hipStream_t stream) {
    static int grid = 0;
    if (grid == 0) {
        if (n_in != N_IN || out_size != (int)O_END || ws_size < WS_END) { fprintf(stderr, "kernel_launch: unexpected shapes: n_in %d out %d ws %zu (need %zu)\n", n_in, out_size, ws_size, (size_t)WS_END); grid = -1; return; }
        int dev = 0, cus = 0;
        if (hipGetDevice(&dev) != hipSuccess || hipDeviceGetAttribute(&cus, hipDeviceAttributeMultiprocessorCount, dev) != hipSuccess) { grid = -1; return; }
        if (hipFuncSetAttribute((const void*)mk_fwd, hipFuncAttributeMaxDynamicSharedMemorySize, LDS_BYTES) != hipSuccess) { grid = -1; return; }
        grid = cus;
    }
    if (grid < 0) return;
    (void)hipMemsetAsync((char*)d_ws + WS_CTL, 0, CTL_ZERO_BYTES, stream);
    Args a{};
    for (int i = 0; i < N_IN; ++i) a.in[i] = (const float*)d_in[i];
    a.out = (float*)d_out; a.ws = (unsigned char*)d_ws;
#if MK_N_LAUNCHES == 1
    a.ph_lo = 0; a.ph_hi = NPH; a.li = 0;
    hipLaunchKernelGGL(mk_fwd, dim3(grid), dim3(NWAVES * 64), LDS_BYTES, stream, a);
#else
    for (int p = 0; p < NPH; ++p) { a.ph_lo = p; a.ph_hi = p + 1; a.li = p; hipLaunchKernelGGL(mk_fwd, dim3(grid), dim3(NWAVES * 64), LDS_BYTES, stream, a); }
#endif
}
```

```cpp
#include <hip/hip_runtime.h>
#include <cstdio>
#include <cstdint>

#ifndef MK_N_LAUNCHES
#define MK_N_LAUNCHES 1
#endif

namespace pg8 {
#define PG8_LAS __attribute__((address_space(3)))
typedef unsigned short bf16_t;
typedef short bf16x8 __attribute__((ext_vector_type(8)));
typedef float f32x4 __attribute__((ext_vector_type(4)));
typedef unsigned u32x4 __attribute__((ext_vector_type(4)));
constexpr int BM = 256, BK = 64, HALF = 128, HTB = HALF * BK * 2, STAGE_BYTES = 8 * HTB, NXCD = 8, WGM = 8;

__host__ __device__ __forceinline__ int lds_byte(int r, int c) { const int st = (r >> 4) * 2 + (c >> 5), rr = r & 15, cc = c & 31, ob = rr * 64 + cc * 2; return st * 1024 + (ob ^ (((ob >> 9) & 1) << 5)); }
__host__ __device__ __forceinline__ void stage_rc(int b, int& R, int& C) { const int st = b / 1024, sb = b % 1024, swz = sb ^ (((sb >> 9) & 1) << 5); R = (st >> 1) * 16 + swz / 64; C = (st & 1) * 32 + (swz % 64) / 2; }
__host__ __device__ __forceinline__ int perm32(int rho) { const int n = rho >> 4, i = rho & 15; return 8 * (i >> 2) + 4 * n + (i & 3); }

struct Unit { int pm, pn; };
struct Gemm { const bf16_t* A; const bf16_t* Bt; int lda, ldb, K; };

struct StaticOrder {
    int nM, nN, nwg, G, c;
    __host__ __device__ void init(int nM_, int nN_, int G_, int c_) { nM = nM_; nN = nN_; nwg = nM * nN; G = G_; c = c_; }
    __host__ __device__ bool next(int i, Unit& u) const {
        const long L = (long)i * G + c; if (L >= nwg) return false;
        int wgid = (int)L; { const int q = nwg / NXCD, r = nwg % NXCD, xcd = wgid % NXCD, off = wgid / NXCD; wgid = (xcd < r ? xcd * (q + 1) : r * (q + 1) + (xcd - r) * q) + off; }
        const int nig = WGM * nN, gid = wgid / nig, fm = gid * WGM, gsz = (nM - fm) < WGM ? (nM - fm) : WGM;
        u.pm = fm + ((wgid % nig) % gsz); u.pn = (wgid % nig) / gsz; return true;
    }
};

typedef float f32x2_t __attribute__((ext_vector_type(2))); typedef __bf16 bf16x2_t __attribute__((ext_vector_type(2)));
__device__ __forceinline__ unsigned cvt_pk_bf16(float lo, float hi) { f32x2_t v = {lo, hi}; bf16x2_t b = __builtin_convertvector(v, bf16x2_t); return __builtin_bit_cast(unsigned, b); }
__device__ __forceinline__ float bflo(unsigned w) { return __uint_as_float(w << 16); }
__device__ __forceinline__ float bfhi(unsigned w) { return __uint_as_float(w & 0xffff0000u); }
__device__ __forceinline__ float sigmoidf_(float x) { return __builtin_amdgcn_rcpf(1.0f + __builtin_amdgcn_exp2f(-1.4426950408889634f * x)); }

struct EpiZ {
    static constexpr bool PERM = true, AFTER_DRAIN = false, KHOOK = false;
    bf16_t* Z; int ldz; float* pool_p; float* pool_s;
    __device__ __forceinline__ void operator()(const f32x4 (&acc)[2][2][4][2], const Unit& u, int wr, int wc, int fr, int fq) const {
        const int row0 = u.pm * BM + wr * 64 + fr, col0 = u.pn * BM + wc * 32 + 8 * fq;
#pragma unroll
        for (int ai = 0; ai < 2; ++ai)
#pragma unroll
            for (int m = 0; m < 4; ++m) {
                const int r = row0 + ai * HALF + m * 16; bf16_t* rowp = Z + (size_t)r * ldz + col0;
                float* prow = nullptr;
                if (u.pn < 2) {
                    if (r < 16384) { const int t = r & 2047; if (t >= 2033) prow = pool_p + (size_t)((r >> 11) * 15 + (t - 2033)) * 512; }
                    else { const int rs = r - 16384, t = rs & 63; if (t >= 49) prow = pool_s + (size_t)((rs >> 6) * 15 + (t - 49)) * 512; }
                }
#pragma unroll
                for (int bj = 0; bj < 2; ++bj) {
                    const f32x4 v0 = acc[ai][bj][m][0], v1 = acc[ai][bj][m][1];
                    u32x4 w; w.x = cvt_pk_bf16(v0[0], v0[1]); w.y = cvt_pk_bf16(v0[2], v0[3]); w.z = cvt_pk_bf16(v1[0], v1[1]); w.w = cvt_pk_bf16(v1[2], v1[3]);
                    *(u32x4*)(rowp + bj * HALF) = w;
                    if (prow) { *(f32x4*)(prow + col0 + bj * HALF) = v0; *(f32x4*)(prow + col0 + bj * HALF + 4) = v1; }
                }
            }
    }
};
struct EpiGm {
    static constexpr bool PERM = true, AFTER_DRAIN = false, KHOOK = false;
    bf16_t* Z; int ldz;
    __device__ __forceinline__ void operator()(const f32x4 (&acc)[2][2][4][2], const Unit& u, int wr, int wc, int fr, int fq) const {
        const int row0 = u.pm * BM + wr * 64 + fr, col0 = u.pn * BM + wc * 32 + 8 * fq;
#pragma unroll
        for (int ai = 0; ai < 2; ++ai)
#pragma unroll
            for (int m = 0; m < 4; ++m) {
                bf16_t* rowp = Z + (size_t)(row0 + ai * HALF + m * 16) * ldz + col0;
#pragma unroll
                for (int bj = 0; bj < 2; ++bj) {
                    const f32x4 v0 = acc[ai][bj][m][0], v1 = acc[ai][bj][m][1];
                    u32x4 w; w.x = cvt_pk_bf16(sigmoidf_(v0[0]), sigmoidf_(v0[1])); w.y = cvt_pk_bf16(sigmoidf_(v0[2]), sigmoidf_(v0[3]));
                    w.z = cvt_pk_bf16(sigmoidf_(v1[0]), sigmoidf_(v1[1])); w.w = cvt_pk_bf16(sigmoidf_(v1[2]), sigmoidf_(v1[3]));
                    *(u32x4*)(rowp + bj * HALF) = w;
                }
            }
    }
};
struct EpiMerge {
    static constexpr bool PERM = true, AFTER_DRAIN = false, KHOOK = true;
    const bf16_t* G; int ldg; bf16_t* Mo; int ldm;
    __device__ __forceinline__ void khook(f32x4 (&acc)[2][2][4][2], const Unit& u, int t, int wr, int wc, int fr, int fq) const {
        if (t != 8 && t != 16) return;
        const int br = (t == 8) ? 0 : 1;
        asm volatile("" : "+v"(fr), "+v"(fq));
        const int row0 = u.pm * BM + wr * 64 + fr, col0 = u.pn * BM + wc * 32 + 8 * fq;
#pragma unroll
        for (int ai = 0; ai < 2; ++ai)
#pragma unroll
            for (int m = 0; m < 4; ++m) {
                const bf16_t* gp = G + (size_t)(row0 + ai * HALF + m * 16) * ldg + br * 1024 + col0;
#pragma unroll
                for (int bj = 0; bj < 2; ++bj) {
                    const u32x4 nu = *(const u32x4*)(gp + bj * HALF), de = *(const u32x4*)(gp + 1024 + bj * HALF);
                    f32x4 r0, r1;
                    r0[0] = bflo(nu.x) * __builtin_amdgcn_rcpf(bflo(de.x)); r0[1] = bfhi(nu.x) * __builtin_amdgcn_rcpf(bfhi(de.x));
                    r0[2] = bflo(nu.y) * __builtin_amdgcn_rcpf(bflo(de.y)); r0[3] = bfhi(nu.y) * __builtin_amdgcn_rcpf(bfhi(de.y));
                    r1[0] = bflo(nu.z) * __builtin_amdgcn_rcpf(bflo(de.z)); r1[1] = bfhi(nu.z) * __builtin_amdgcn_rcpf(bfhi(de.z));
                    r1[2] = bflo(nu.w) * __builtin_amdgcn_rcpf(bflo(de.w)); r1[3] = bfhi(nu.w) * __builtin_amdgcn_rcpf(bfhi(de.w));
                    acc[ai][bj][m][0] *= r0; acc[ai][bj][m][1] *= r1;
                }
                asm volatile("" ::: "memory");
            }
    }
    __device__ __forceinline__ void operator()(const f32x4 (&acc)[2][2][4][2], const Unit& u, int wr, int wc, int fr, int fq) const {
        const int row0 = u.pm * BM + wr * 64 + fr, col0 = u.pn * BM + wc * 32 + 8 * fq;
#pragma unroll
        for (int ai = 0; ai < 2; ++ai)
#pragma unroll
            for (int m = 0; m < 4; ++m) {
                const int r = row0 + ai * HALF + m * 16;
                const bf16_t* gp = G + (size_t)r * ldg + 2048 + col0; bf16_t* rowp = Mo + (size_t)r * ldm + col0;
#pragma unroll
                for (int bj = 0; bj < 2; ++bj) {
                    const u32x4 g = *(const u32x4*)(gp + bj * HALF);
                    const f32x4 v0 = acc[ai][bj][m][0], v1 = acc[ai][bj][m][1];
                    u32x4 w; w.x = cvt_pk_bf16(v0[0] * bflo(g.x), v0[1] * bfhi(g.x)); w.y = cvt_pk_bf16(v0[2] * bflo(g.y), v0[3] * bfhi(g.y));
                    w.z = cvt_pk_bf16(v1[0] * bflo(g.z), v1[1] * bfhi(g.z)); w.w = cvt_pk_bf16(v1[2] * bflo(g.w), v1[3] * bfhi(g.w));
                    *(u32x4*)(rowp + bj * HALF) = w;
                }
            }
    }
};
struct EpiF32 {
    static constexpr bool PERM = false, AFTER_DRAIN = false, KHOOK = false;
    float* C; int ldc;
    __device__ __forceinline__ void operator()(const f32x4 (&acc)[2][2][4][2], const Unit& u, int wr, int wc, int fr, int fq) const {
        const int row0 = u.pm * BM + wr * 64 + fr, col0 = u.pn * BM + wc * 32 + 4 * fq;
#pragma unroll
        for (int ai = 0; ai < 2; ++ai)
#pragma unroll
            for (int m = 0; m < 4; ++m) { float* rowp = C + (size_t)(row0 + ai * HALF + m * 16) * ldc + col0;
#pragma unroll
                for (int bj = 0; bj < 2; ++bj)
#pragma unroll
                    for (int n = 0; n < 2; ++n) *(f32x4*)(rowp + bj * HALF + n * 16) = acc[ai][bj][m][n]; }
    }
};

template <class Epi, class Sched, bool ALIGN_EPI>
__device__ __forceinline__ void gemm_phase(PG8_LAS unsigned char* lds, const Gemm g, const Sched& S, const Epi& E) {
    int tid_ = threadIdx.x; asm volatile("" : "+v"(tid_));
    const int tid = tid_, wid = __builtin_amdgcn_readfirstlane(tid >> 6), lane = tid & 63, wr = wid >> 2, wc = wid & 3, fr = lane & 15, fq = lane >> 4;
    const int K = g.K, nt = K / BK;
    unsigned voffA[2], voffB[2];
#pragma unroll
    for (int i = 0; i < 2; ++i) { int R, C; stage_rc(tid * 16 + i * 8192, R, C); const int Rb = Epi::PERM ? ((R & ~31) + perm32(R & 31)) : R;
        voffA[i] = (unsigned)(R * g.lda + C) * 2u; voffB[i] = (unsigned)(Rb * g.ldb + C) * 2u; }
    const size_t kstep = (size_t)(BK * 2);
    const size_t hstepA = (size_t)HALF * g.lda * 2, hstepB = (size_t)HALF * g.ldb * 2;
    const size_t tstepA = 2 * hstepA, tstepB = 2 * hstepB;
    const unsigned ldsw = (unsigned)wid * 1024u;
    const int aoff = lds_byte(wr * 64 + fr, fq * 8), boff = lds_byte(wc * 32 + fr, fq * 8);
#define PG8_SA(b, h) (((b) * 2 + (h)) * HTB)
#define PG8_SB(b, h) ((4 + (b) * 2 + (h)) * HTB)
#define PG8_STAGE(bufoff, gbase, voff) do { _Pragma("unroll") for (int _i = 0; _i < 2; ++_i) \
        __builtin_amdgcn_global_load_lds((const unsigned*)((const char*)(gbase) + (voff)[_i]), (PG8_LAS unsigned*)(lds + (bufoff) + ldsw + _i * 8192), 16, 0, 0); } while (0)
#define PG8_LDA(dst, b, h) do { _Pragma("unroll") for (int m = 0; m < 4; ++m) _Pragma("unroll") for (int k = 0; k < 2; ++k) dst[m][k] = *(const PG8_LAS bf16x8*)(lds + PG8_SA(b, h) + aoff + m * 2048 + k * 1024); } while (0)
#define PG8_LDB(dst, b, h) do { _Pragma("unroll") for (int n = 0; n < 2; ++n) _Pragma("unroll") for (int k = 0; k < 2; ++k) dst[n][k] = *(const PG8_LAS bf16x8*)(lds + PG8_SB(b, h) + boff + n * 2048 + k * 1024); } while (0)
#define PG8_MMA(ai, bj, At, Bt) do { __builtin_amdgcn_s_setprio(1); _Pragma("unroll") for (int m = 0; m < 4; ++m) _Pragma("unroll") for (int n = 0; n < 2; ++n) _Pragma("unroll") for (int k = 0; k < 2; ++k) \
        acc[ai][bj][m][n] = __builtin_amdgcn_mfma_f32_16x16x32_bf16(Bt[n][k], At[m][k], acc[ai][bj][m][n], 0, 0, 0); __builtin_amdgcn_s_setprio(0); } while (0)
#define PG8_WAIT_V(n) asm volatile("s_waitcnt vmcnt(" #n ")" ::: "memory")
#define PG8_WAIT_L(n) asm volatile("s_waitcnt lgkmcnt(" #n ")" ::: "memory")
#define PG8_BAR __builtin_amdgcn_s_barrier()
#define PG8_SCHED __builtin_amdgcn_sched_barrier(0)
    Unit cur, nxt; int ui = 0;
    if (!S.next(0, cur)) return;
    f32x4 acc[2][2][4][2];
#pragma unroll
    for (int a = 0; a < 2; ++a)
#pragma unroll
        for (int b = 0; b < 2; ++b)
#pragma unroll
            for (int m = 0; m < 4; ++m)
#pragma unroll
                for (int n = 0; n < 2; ++n) acc[a][b][m][n] = (f32x4){0.f, 0.f, 0.f, 0.f};
    bf16x8 At[4][2], B0[2][2], B1[2][2];
    const char* cA = (const char*)g.A + (size_t)cur.pm * tstepA; const char* cB = (const char*)g.Bt + (size_t)cur.pn * tstepB;
    PG8_STAGE(PG8_SB(0, 0), cB, voffB); PG8_STAGE(PG8_SB(0, 1), cB + hstepB, voffB); PG8_STAGE(PG8_SA(0, 0), cA, voffA); PG8_STAGE(PG8_SA(0, 1), cA + hstepA, voffA);
    if (wr == 1) PG8_BAR;
    PG8_WAIT_V(2); PG8_BAR;
    PG8_STAGE(PG8_SB(1, 0), cB + kstep, voffB); PG8_STAGE(PG8_SA(1, 0), cA + kstep, voffA); PG8_STAGE(PG8_SB(1, 1), cB + hstepB + kstep, voffB);
    PG8_WAIT_V(6); PG8_BAR;
    for (;;) {
        const bool has_next = S.next(ui + 1, nxt);
        const char* nA = has_next ? (const char*)g.A + (size_t)nxt.pm * tstepA : cA; const char* nB = has_next ? (const char*)g.Bt + (size_t)nxt.pn * tstepB : cB;
        for (int t = 0; t < nt; t += 2) {
            const bool last = (t == nt - 2);
            const char* a1 = cA + (size_t)(t + 1) * kstep;
            const char* a2 = last ? nA : cA + (size_t)(t + 2) * kstep; const char* b2 = last ? nB : cB + (size_t)(t + 2) * kstep;
            const char* a3 = a2 + kstep; const char* b3 = b2 + kstep;
            if constexpr (Epi::KHOOK) E.khook(acc, cur, t, wr, wc, fr, fq);
            PG8_LDB(B0, 0, 0); PG8_LDB(B1, 0, 1); PG8_SCHED; PG8_LDA(At, 0, 0); PG8_STAGE(PG8_SA(1, 1), a1 + hstepA, voffA);
            PG8_WAIT_V(8); PG8_WAIT_L(0); PG8_BAR; PG8_MMA(0, 0, At, B0); PG8_MMA(0, 1, At, B1); PG8_BAR; PG8_SCHED;
            PG8_LDA(At, 0, 1); PG8_STAGE(PG8_SB(0, 0), b2, voffB); PG8_STAGE(PG8_SB(0, 1), b2 + hstepB, voffB); PG8_STAGE(PG8_SA(0, 0), a2, voffA);
            PG8_WAIT_V(8); PG8_WAIT_L(0); PG8_BAR; PG8_MMA(1, 0, At, B0); PG8_MMA(1, 1, At, B1); PG8_BAR; PG8_SCHED;
            PG8_LDB(B0, 1, 0); PG8_LDB(B1, 1, 1); PG8_SCHED; PG8_LDA(At, 1, 0); PG8_STAGE(PG8_SA(0, 1), a2 + hstepA, voffA);
            PG8_WAIT_V(8); PG8_WAIT_L(0); PG8_BAR; PG8_MMA(0, 0, At, B0); PG8_MMA(0, 1, At, B1); PG8_BAR; PG8_SCHED;
            PG8_LDA(At, 1, 1); PG8_STAGE(PG8_SB(1, 0), b3, voffB); PG8_STAGE(PG8_SB(1, 1), b3 + hstepB, voffB); PG8_STAGE(PG8_SA(1, 0), a3, voffA);
            PG8_WAIT_V(8); PG8_WAIT_L(0); PG8_BAR; PG8_MMA(1, 0, At, B0); PG8_MMA(1, 1, At, B1); PG8_BAR; PG8_SCHED;
        }
        if constexpr (ALIGN_EPI) { if (wr == 0) PG8_BAR; }
        E(acc, cur, wr, wc, fr, fq);
        if (!has_next) break;
#pragma unroll
        for (int a = 0; a < 2; ++a)
#pragma unroll
            for (int b = 0; b < 2; ++b)
#pragma unroll
                for (int m = 0; m < 4; ++m)
#pragma unroll
                    for (int n = 0; n < 2; ++n) acc[a][b][m][n] = (f32x4){0.f, 0.f, 0.f, 0.f};
        cur = nxt; cA = nA; cB = nB; ++ui;
        if constexpr (ALIGN_EPI) { if (wr == 1) PG8_BAR; }
    }
    PG8_WAIT_V(0);
    if constexpr (!ALIGN_EPI) { if (wr == 0) PG8_BAR; }
    PG8_BAR;
#undef PG8_SA
#undef PG8_SB
#undef PG8_STAGE
#undef PG8_LDA
#undef PG8_LDB
#undef PG8_MMA
#undef PG8_WAIT_V
#undef PG8_WAIT_L
#undef PG8_BAR
#undef PG8_SCHED
}
}

constexpr int NWAVES = 8;
constexpr int DM = 1024, MP = 16384, MS = 512, MT = MP + MS;
constexpr int SEQ = 2048, DSEQ = 64, DEPTH = 2, NB = 8;
constexpr int D_IN = 8720;
constexpr int ZP = 5632;
constexpr int CA = 0, CU = 512, CVB = 1024, CQ = 1536, CK = 2048, CGC = 2560, CGA = 3584, CGB = 4096, CVC = 4608, CY = 3584;
constexpr int N1A = 5632, N1B = 3072, N1 = N1A + N1B;
constexpr float EPS = 1e-6f;
constexpr size_t O_YP = 0, O_YS = 16777216, O_PP = 17301504, O_GP = 17424384, O_PS = 19521536, O_GS = 19644416, O_SV = 21741568, O_END = 22265856;

constexpr size_t MiB = 1u << 20;
constexpr size_t WS_CTL = 0, CTL_ZERO_BYTES = 64 * 1024;
constexpr size_t WS_MOD = 1 * MiB;
constexpr size_t WS_ZLR = 2 * MiB;
constexpr size_t WS_WLR = 3 * MiB + 512 * 1024;
constexpr size_t WS_W1 = 4 * MiB;
constexpr size_t WS_WCAT = 38 * MiB;
constexpr size_t WS_WOUT = 46 * MiB;
constexpr size_t WS_XN = 50 * MiB;
constexpr size_t WS_Z = 83 * MiB;
constexpr size_t WS_ABUF = WS_Z + (size_t)MT * ZP * 2;
constexpr size_t WS_DEC = WS_ABUF + (size_t)1056 * 5120;
constexpr size_t WS_END = WS_DEC + (size_t)1056 * 512;
static_assert(WS_ZLR + (size_t)MT * 16 * 4 <= WS_WLR && WS_W1 + (size_t)2 * N1 * 1024 * 2 <= WS_WCAT && WS_WCAT + (size_t)2 * 1024 * 2048 * 2 <= WS_WOUT && WS_WOUT + (size_t)2 * 1024 * 1024 * 2 <= WS_XN && WS_XN + (size_t)MT * 1024 * 2 <= WS_Z, "ws map");
constexpr int CW_TMO = 0, CW_BAR = 4096;

constexpr int RING_BYTES = 131072, LDSCTL_OFF = RING_BYTES, MISC_OFF = LDSCTL_OFF + 320, LDS_BYTES = 147456;

#define GAS __attribute__((address_space(1)))
#define LAS __attribute__((address_space(3)))
typedef unsigned short bf16;
typedef unsigned v4u __attribute__((ext_vector_type(4)));
typedef unsigned v2u __attribute__((ext_vector_type(2)));
typedef float f32x4 __attribute__((ext_vector_type(4)));
typedef GAS unsigned gu32;
#define RLX_AGENT __ATOMIC_RELAXED, __HIP_MEMORY_SCOPE_AGENT
#define LDS_WAIT() asm volatile("s_waitcnt lgkmcnt(0)" ::: "memory")
__device__ __forceinline__ unsigned f2bf(float f) { unsigned u = __builtin_bit_cast(unsigned, f); return (u + 0x7fffu + ((u >> 16) & 1u)) >> 16; }
__device__ __forceinline__ unsigned pk2(float lo, float hi) { return f2bf(lo) | (f2bf(hi) << 16); }
__device__ __forceinline__ float bf2f(bf16 v) { return __uint_as_float((unsigned)v << 16); }
__device__ __forceinline__ float siluf_(float x) { return x * __builtin_amdgcn_rcpf(1.0f + __expf(-x)); }

#define XB_TMO      128
#define XB_XCNT(j)  (256  + 64 * (j))
#define XB_XSUB(j)  (1280 + 64 * (j))
#define XB_XGEN(j)  (2304 + 64 * (j))
#define XB_TOP      3328
#define XB_TOPGEN   3392
#define XCD_BAR_WORDS 3456
#define XB_SPIN_CAP (1u << 18)
__device__ __forceinline__ unsigned xb_ld(unsigned* p)              { return __hip_atomic_load(p, __ATOMIC_RELAXED, __HIP_MEMORY_SCOPE_AGENT); }
__device__ __forceinline__ unsigned xb_add(unsigned* p, unsigned v) { return __hip_atomic_fetch_add(p, v, __ATOMIC_RELAXED, __HIP_MEMORY_SCOPE_AGENT); }
__device__ __forceinline__ unsigned xb_xcc_id() { return (unsigned)__builtin_amdgcn_s_getreg((3 << 11) | 20) & 0xFu; }
#define XB_SPIN(cond, bar) do { unsigned _sp = 0; while (cond) { __builtin_amdgcn_s_sleep(1); \
    if ((++_sp & 255u) == 0u) { if (xb_ld(&(bar)[XB_TMO])) break; if (_sp > XB_SPIN_CAP) { atomicAdd(&(bar)[XB_TMO], 1u); break; } } } } while (0)
struct XcdBarrier { unsigned* bar; unsigned x; volatile LAS unsigned* st; };
__device__ __forceinline__ XcdBarrier xcd_barrier_post(unsigned* bar, volatile LAS unsigned* st) {
    XcdBarrier b; b.bar = bar; b.x = xb_xcc_id(); b.st = st;
    if (threadIdx.x == 0) (void)xb_add(&bar[XB_XCNT(b.x)], 1u);
    return b;
}
__device__ __forceinline__ void xcd_barrier_complete(unsigned* bar, unsigned x, unsigned& nloc, unsigned& nx) {
    const unsigned G = gridDim.x * gridDim.y * gridDim.z;
    unsigned sum, cnt, mine, sp = 0u;
    for (;;) {
        sum = 0u; cnt = 0u; mine = 0u;
#pragma unroll
        for (unsigned j = 0; j < 16; ++j) { const unsigned c = xb_ld(&bar[XB_XCNT(j)]); sum += c; cnt += (c > 0u) ? 1u : 0u; mine = (j == x) ? c : mine; }
        if (sum == G) break;
        __builtin_amdgcn_s_sleep(1);
        if ((++sp & 255u) == 0u) { if (xb_ld(&bar[XB_TMO])) break; if (sp > XB_SPIN_CAP) { atomicAdd(&bar[XB_TMO], 1u); break; } }
    }
    nloc = mine > 0u ? mine : 1u; nx = cnt > 0u ? cnt : 1u;
}
__device__ __forceinline__ void xcd_barrier(const XcdBarrier& b) {
    asm volatile("s_waitcnt vmcnt(0)" ::: "memory");
    __syncthreads();
    if (threadIdx.x == 0) {
        unsigned* bar = b.bar;
        __builtin_amdgcn_s_waitcnt(0);
        unsigned nloc = b.st[0], nx = b.st[1];
        if (nloc == 0u) { xcd_barrier_complete(bar, b.x, nloc, nx); b.st[0] = nloc; b.st[1] = nx; }
        const unsigned old = xb_add(&bar[XB_XSUB(b.x)], 1u);
        const unsigned gen = old / nloc;
        if (old + 1u == (gen + 1u) * nloc) {
            __builtin_amdgcn_fence(__ATOMIC_RELEASE, "agent");
            asm volatile("s_waitcnt vmcnt(0)" ::: "memory");
            const unsigned og = xb_add(&bar[XB_TOP], 1u);
            const unsigned tg = og / nx;
            if (og + 1u == (tg + 1u) * nx) xb_add(&bar[XB_TOPGEN], 1u);
            else XB_SPIN(xb_ld(&bar[XB_TOPGEN]) == tg, bar);
            __builtin_amdgcn_fence(__ATOMIC_ACQUIRE, "agent");
            xb_add(&bar[XB_XGEN(b.x)], 1u);
            asm volatile("s_waitcnt vmcnt(0)" ::: "memory");
        } else {
            XB_SPIN(xb_ld(&bar[XB_XGEN(b.x)]) == gen, bar);
            __builtin_amdgcn_fence(__ATOMIC_ACQUIRE, "agent");
            asm volatile("s_waitcnt vmcnt(0)" ::: "memory");
        }
    }
    __syncthreads();
}

__device__ __forceinline__ int opq(int x) { asm volatile("" : "+v"(x)); return x; }
struct Frame {
    LAS unsigned char* lds;
    int tid, lane, wave, vcu, G;
};
__device__ __forceinline__ float wave_sum(float v) {
    v += __int_as_float(__builtin_amdgcn_ds_swizzle(__float_as_int(v), 0x041F));
    v += __int_as_float(__builtin_amdgcn_ds_swizzle(__float_as_int(v), 0x081F));
    v += __int_as_float(__builtin_amdgcn_ds_swizzle(__float_as_int(v), 0x101F));
    v += __int_as_float(__builtin_amdgcn_ds_swizzle(__float_as_int(v), 0x201F));
    v += __int_as_float(__builtin_amdgcn_ds_swizzle(__float_as_int(v), 0x401F));
    const auto rr = __builtin_amdgcn_permlane32_swap(__float_as_uint(v), __float_as_uint(v), false, false);
    return __uint_as_float(rr[0]) + __uint_as_float(rr[1]);
}
enum { I_XP = 0, I_XS, I_SPOOL, I_SGLA, I_CP, I_CS, I_ADAW, I_ADAB, I_PREG, I_POSTG, I_WIN, I_POOLW, I_POOLS, I_SGUG, I_SGUW, I_SGUB, I_WA2, I_BA, I_GLAG, I_WOA, I_WOB, I_WOC, I_WOUT, N_IN };
struct Args { const float* in[N_IN]; float* out; unsigned char* ws; int ph_lo, ph_hi, li, pad; };

__device__ __forceinline__ void transpose_item(const float* src, int ldsrc, bf16* dst, int ldd, LAS float* scr, int lane) {
#pragma unroll 8
    for (int i = 0; i < 32; ++i) { const int kk = 2 * i + (lane >> 5); scr[kk * 33 + (lane & 31)] = src[(size_t)kk * ldsrc + (lane & 31)]; }
    LDS_WAIT(); asm volatile("" ::: "memory");
    const int c = lane & 7;
#pragma unroll
    for (int j = 0; j < 4; ++j) { const int n = (lane >> 3) + 8 * j; const LAS float* s = scr + (8 * c) * 33 + n;
        v4u o; o.x = pk2(s[0 * 33], s[1 * 33]); o.y = pk2(s[2 * 33], s[3 * 33]); o.z = pk2(s[4 * 33], s[5 * 33]); o.w = pk2(s[6 * 33], s[7 * 33]);
        *(GAS v4u*)(dst + (size_t)n * ldd + 8 * c) = o; }
    LDS_WAIT(); asm volatile("" ::: "memory");
}
__device__ __forceinline__ int w1_src_col(int n) {
    if (n < 512) return n;
    if (n < 1024) return 1024 + (n - 512);
    if (n < 1536) return 1536 + (n - 1024);
    if (n < 2048) return 2560 + (n - 1536);
    if (n < 2560) return 3072 + (n - 2048);
    if (n < 3584) return 4608 + (n - 2560);
    if (n < 4096) return 512 + (n - 3584);
    if (n < 4608) return 2048 + (n - 4096);
    if (n < 5632) return 3584 + (n - 4608);
    return 5648 + (n - 5632);
}
__device__ __forceinline__ int batch_of_row(int m) { return m < MP ? (m >> 11) : 8 + ((m - MP) >> 6); }

__device__ __forceinline__ void xn_row(const float* xrow, const float* g, const float* mod  , bf16* orow, int lane) {
    const GAS f32x4* xr = (const GAS f32x4*)xrow + lane;
    f32x4 v[4]; float s = 0.f;
#pragma unroll
    for (int j = 0; j < 4; ++j) { v[j] = xr[64 * j]; s += (v[j].x * v[j].x + v[j].y * v[j].y) + (v[j].z * v[j].z + v[j].w * v[j].w); }
    const float rstd = 1.0f / sqrtf(wave_sum(s) * (1.f / DM) + EPS);
    GAS unsigned long long* o8 = (GAS unsigned long long*)orow + lane;
#pragma unroll
    for (int j = 0; j < 4; ++j) {
        const int c = 4 * lane + 256 * j;
        const f32x4 gg = *(const f32x4*)(g + c), sh = *(const f32x4*)(mod + c), sc = *(const f32x4*)(mod + 1024 + c);
        const f32x4 h = (v[j] * rstd) * gg * (sc + 1.0f) + sh;
        o8[64 * j] = (unsigned long long)pk2(h.x, h.y) | ((unsigned long long)pk2(h.z, h.w) << 32);
    }
}

constexpr int NPH = 18;

__global__ void __launch_bounds__(NWAVES * 64, 2) mk_fwd(Args args) {
    extern __shared__ __attribute__((aligned(16))) unsigned char lds[];
    Frame F;
    F.lds = (LAS unsigned char*)lds;
    volatile LAS unsigned* MISC = (volatile LAS unsigned*)(F.lds + MISC_OFF);
    F.tid = threadIdx.x; F.lane = F.tid & 63; F.wave = __builtin_amdgcn_readfirstlane(F.tid >> 6);
    F.G = gridDim.x; { const int bx = blockIdx.x; F.vcu = (F.G % 8 == 0) ? (bx % 8) * (F.G / 8) + bx / 8 : bx; }
    unsigned char* ws = args.ws;
    gu32* ctl = (gu32*)(ws + WS_CTL);
    for (int u = F.tid; u < (LDS_BYTES - LDSCTL_OFF) / 4; u += NWAVES * 64) ((LAS unsigned*)(F.lds + LDSCTL_OFF))[u] = 0u;
    __syncthreads();
    XcdBarrier bar; bar.bar = (unsigned*)(ctl + CW_BAR); bar.x = 0; bar.st = nullptr;
    if (MK_N_LAUNCHES == 1) bar = xcd_barrier_post((unsigned*)(ctl + CW_BAR), MISC + 8);
#define GRID_BAR() do { if (MK_N_LAUNCHES == 1) xcd_barrier(bar); } while (0)
    const int lo = args.ph_lo, hi = args.ph_hi;
#ifndef ABLMASK
#define ABLMASK 0xffff
#endif
#define IN(k) (lo <= (k) && (k) < hi)
#define PHASE_BEGIN() do { F.tid = opq((int)threadIdx.x); F.lane = F.tid & 63; } while (0)
#define KON(b) ((ABLMASK >> (b)) & 1)
    float* mod_all = (float*)(ws + WS_MOD);
    float* zlr = (float*)(ws + WS_ZLR);
    float* wlr_all = (float*)(ws + WS_WLR);
    bf16* XN = (bf16*)(ws + WS_XN);
    bf16* Z = (bf16*)(ws + WS_Z);
    float* OUTF = (float*)(ws + WS_Z);
    float* dout = args.out;
    const int gw = F.vcu * NWAVES + F.wave, NGW = F.G * NWAVES;

    if (KON(0) && IN(0)) {
        PHASE_BEGIN();
        LAS float* scr = (LAS float*)(F.lds + F.wave * 16384);
        constexpr int I_W1 = (1024 / 64) * (N1 / 32);
        constexpr int I_OA = (512 / 64) * 32, I_OC = (1024 / 64) * 32, I_OUT = (1024 / 64) * 32;
        constexpr int PER_L = I_W1 + 2 * I_OA + I_OC + I_OUT;
        for (int it = gw; it < 2 * PER_L; it += NGW) {
            const int l = it / PER_L; int r = it % PER_L;
            if (r < I_W1) { const int nb = r % (N1 / 32), kb = r / (N1 / 32); const int n0 = 32 * nb, k0 = 64 * kb;
                transpose_item(args.in[I_WIN] + (size_t)l * 1024 * D_IN + (size_t)k0 * D_IN + w1_src_col(n0), D_IN, (bf16*)(ws + WS_W1) + ((size_t)l * N1 + n0) * 1024 + k0, 1024, scr, F.lane); continue; }
            r -= I_W1;
            bf16* wcat = (bf16*)(ws + WS_WCAT) + (size_t)l * 1024 * 2048;
            if (r < I_OA) { const int nb = r % 32, kb = r / 32; transpose_item(args.in[I_WOA] + (size_t)l * 512 * 1024 + (size_t)(64 * kb) * 1024 + 32 * nb, 1024, wcat + (size_t)(32 * nb) * 2048 + 64 * kb, 2048, scr, F.lane); continue; }
            r -= I_OA;
            if (r < I_OA) { const int nb = r % 32, kb = r / 32; transpose_item(args.in[I_WOB] + (size_t)l * 512 * 1024 + (size_t)(64 * kb) * 1024 + 32 * nb, 1024, wcat + (size_t)(32 * nb) * 2048 + 512 + 64 * kb, 2048, scr, F.lane); continue; }
            r -= I_OA;
            if (r < I_OC) { const int nb = r % 32, kb = r / 32; transpose_item(args.in[I_WOC] + (size_t)l * 1024 * 1024 + (size_t)(64 * kb) * 1024 + 32 * nb, 1024, wcat + (size_t)(32 * nb) * 2048 + 1024 + 64 * kb, 2048, scr, F.lane); continue; }
            r -= I_OC;
            { const int nb = r % 32, kb = r / 32; transpose_item(args.in[I_WOUT] + (size_t)l * 1024 * 1024 + (size_t)(64 * kb) * 1024 + 32 * nb, 1024, (bf16*)(ws + WS_WOUT) + (size_t)l * 1024 * 1024 + (size_t)(32 * nb) * 1024 + 64 * kb, 1024, scr, F.lane); }
        }
        for (int i = blockIdx.x * 512 + F.tid; i < 2 * 16 * 1024; i += F.G * 512) { const int l = i >> 14, r = (i >> 10) & 15, k = i & 1023; wlr_all[i] = args.in[I_WIN][(size_t)l * 1024 * D_IN + (size_t)k * D_IN + 5632 + r]; }
        __syncthreads();
        LAS float* sc = (LAS float*)F.lds;
        LAS float* part = (LAS float*)(F.lds + 65536);
        for (int it = F.vcu; it < 2 * 48; it += F.G) {
            const int l = it / 48, j0 = (it % 48) * 64;
            for (int i = F.tid; i < 16 * 1024; i += 512) { const int bi = i >> 10, k = i & 1023; const float cv = bi < 8 ? args.in[I_CP][bi * 1024 + k] : args.in[I_CS][(bi - 8) * 1024 + k]; sc[i] = siluf_(cv); }
            __syncthreads();
            float a[16];
#pragma unroll
            for (int b = 0; b < 16; ++b) a[b] = 0.f;
            const float* wp = args.in[I_ADAW] + (size_t)l * 1024 * 3072 + j0 + F.lane;
            for (int k = F.wave * 128; k < F.wave * 128 + 128; ++k) {
                const float w = wp[(size_t)k * 3072];
#pragma unroll
                for (int b = 0; b < 16; ++b) a[b] += sc[b * 1024 + k] * w;
            }
#pragma unroll
            for (int b = 0; b < 16; ++b) part[(F.wave * 16 + b) * 64 + F.lane] = a[b];
            __syncthreads();
            for (int i = F.tid; i < 16 * 64; i += 512) { const int b = i >> 6, j = i & 63; float s = 0.f;
#pragma unroll
                for (int w = 0; w < 8; ++w) s += part[(w * 16 + b) * 64 + j];
                mod_all[((size_t)l * 16 + b) * 3072 + j0 + j] = s + args.in[I_ADAB][l * 3072 + j0 + j]; }
            __syncthreads();
        }
        GRID_BAR();
    }
    if (KON(1) && IN(1)) {
        PHASE_BEGIN();
        for (int m = gw; m < MT; m += NGW) {
            const float* xrow = m < MP ? args.in[I_XP] + (size_t)m * DM : args.in[I_XS] + (size_t)(m - MP) * DM;
            xn_row(xrow, args.in[I_PREG], mod_all + (size_t)batch_of_row(m) * 3072, XN + (size_t)m * DM, F.lane);
        }
        GRID_BAR();
    }
    for (int l = 0; l < DEPTH; ++l) {
        const int pb = 2 + 8 * l;
        const float* mod_l = mod_all + (size_t)l * 16 * 3072;
        const bf16* W1 = (const bf16*)(ws + WS_W1) + (size_t)l * N1 * 1024;
        if (KON(2) && IN(pb + 0)) {
        PHASE_BEGIN();
            const float* wl = wlr_all + (size_t)l * 16 * 1024;
            for (int m = gw; m < MT; m += NGW) {
                const GAS v4u* xr = (const GAS v4u*)(XN + (size_t)m * DM) + F.lane * 2;
                const v4u x0 = xr[0], x1 = xr[1];
                float xv[16];
                xv[0] = pg8::bflo(x0.x); xv[1] = pg8::bfhi(x0.x); xv[2] = pg8::bflo(x0.y); xv[3] = pg8::bfhi(x0.y); xv[4] = pg8::bflo(x0.z); xv[5] = pg8::bfhi(x0.z); xv[6] = pg8::bflo(x0.w); xv[7] = pg8::bfhi(x0.w);
                xv[8] = pg8::bflo(x1.x); xv[9] = pg8::bfhi(x1.x); xv[10] = pg8::bflo(x1.y); xv[11] = pg8::bfhi(x1.y); xv[12] = pg8::bflo(x1.z); xv[13] = pg8::bfhi(x1.z); xv[14] = pg8::bflo(x1.w); xv[15] = pg8::bfhi(x1.w);
                float myv = 0.f;
                for (int r = 0; r < 16; ++r) {
                    const float* wr_ = wl + r * 1024 + 16 * F.lane; float s = 0.f;
#pragma unroll
                    for (int j = 0; j < 16; ++j) s += xv[j] * wr_[j];
                    s = wave_sum(s);
                    if (F.lane == r) myv = s;
                }
                if (F.lane < 16) zlr[(size_t)m * 16 + F.lane] = myv;
            }
            __syncthreads();
            pg8::Gemm g{XN, W1, 1024, 1024, 1024}; pg8::StaticOrder S; S.init(MT / 256, N1A / 256, F.G, (int)blockIdx.x);
            pg8::EpiZ E{Z, ZP, dout + O_PP + (size_t)l * NB * 15 * 512, dout + O_PS + (size_t)l * NB * 15 * 512};
            pg8::gemm_phase<pg8::EpiZ, pg8::StaticOrder, true>(F.lds, g, S, E);
            GRID_BAR();
        }
        if (KON(3) && IN(pb + 1)) {
        PHASE_BEGIN();
            {
                LAS float* at = (LAS float*)F.lds;
                LAS float* dt = (LAS float*)(F.lds + 79 * 128 * 4);
                const float* pw = args.in[I_POOLW] + (size_t)l * 4 * 128 * 128;
                for (int it = F.vcu; it < (MT / 64) * 4; it += F.G) {
                    const int tile = it >> 2, g = it & 3, w = 2 << g;
                    const int m0 = tile * 64; const bool smp = m0 >= MP;
                    const int bb = smp ? ((m0 - MP) >> 6) : (m0 >> 11), t0 = smp ? 0 : (m0 & 2047), pos0 = smp ? SEQ : 0;
                    for (int i = F.tid; i < 79 * 128; i += 512) {
                        const int ri = i >> 7, c = i & 127, t = t0 - 15 + ri; float v;
                        if (t >= 0) v = bf2f(Z[(size_t)(m0 - 15 + ri) * ZP + CA + g * 128 + c]);
                        else v = smp ? args.in[I_SPOOL][(((size_t)l * NB + bb) * 15 + (15 + t)) * 512 + g * 128 + c] : 0.f;
                        at[i] = v;
                    }
                    __syncthreads();
                    for (int i = F.tid; i < 64 * 128; i += 512) {
                        const int tt = i >> 7, c = i & 127; float s = 0.f;
                        for (int k = 0; k < w; ++k) s += at[(tt + 15 - k) * 128 + c];
                        const int pos = pos0 + t0 + tt; const float cnt = (float)((pos + 1) < w ? (pos + 1) : w);
                        dt[i] = s / cnt - at[(tt + 15) * 128 + c];
                    }
                    __syncthreads();
                    {
                        const int cp = F.tid & 127, tq = F.tid >> 7;
                        float acc[16];
#pragma unroll
                        for (int j = 0; j < 16; ++j) acc[j] = 0.f;
                        for (int c = 0; c < 128; ++c) {
                            const float wv = pw[((size_t)g * 128 + c) * 128 + cp];
#pragma unroll
                            for (int j = 0; j < 16; ++j) acc[j] += dt[(tq * 16 + j) * 128 + c] * wv;
                        }
                        const float psc = args.in[I_POOLS][l * 512 + g * 128 + cp];
#pragma unroll
                        for (int j = 0; j < 16; ++j) {
                            bf16* p = Z + (size_t)(m0 + tq * 16 + j) * ZP + CGA + g * 128 + cp;
                            const float ga = bf2f(*p);
                            *p = (bf16)f2bf(acc[j] * psc * siluf_(ga));
                        }
                    }
                    __syncthreads();
                }
            }
            {
                LAS float* vn = (LAS float*)F.lds;
                const float* sw = args.in[I_SGUW] + (size_t)l * 4 * 128 * 128;
                for (int it = F.vcu; it < 136 * 4; it += F.G) {
                    const int ch = it >> 2, g = it & 3;
                    const bool smp = ch >= 128; const int L = smp ? 64 : 128, m0 = smp ? MP + (ch - 128) * 64 : ch * 128;
                    for (int j = F.wave; j < L; j += 8) {
                        const v4u raw = *(const GAS v4u*)(Z + (size_t)(m0 + j) * ZP + CVB + 8 * F.lane);
                        float x[8]; x[0] = pg8::bflo(raw.x); x[1] = pg8::bfhi(raw.x); x[2] = pg8::bflo(raw.y); x[3] = pg8::bfhi(raw.y); x[4] = pg8::bflo(raw.z); x[5] = pg8::bfhi(raw.z); x[6] = pg8::bflo(raw.w); x[7] = pg8::bfhi(raw.w);
                        float s = 0.f;
#pragma unroll
                        for (int e = 0; e < 8; ++e) s += x[e];
                        const float mu = wave_sum(s) * (1.f / 512.f); float q = 0.f;
#pragma unroll
                        for (int e = 0; e < 8; ++e) { x[e] -= mu; q += x[e] * x[e]; }
                        const float rstd = 1.0f / sqrtf(wave_sum(q) * (1.f / 512.f) + EPS);
                        if ((F.lane >> 4) == g) {
                            const int c0 = 8 * (F.lane & 15);
#pragma unroll
                            for (int e = 0; e < 8; ++e) {
                                const float y = x[e] * rstd * args.in[I_SGUG][l * 512 + g * 128 + c0 + e];
                                vn[j * 128 + c0 + e] = y;
                                if (smp) dout[O_SV + (((size_t)l * NB + (ch - 128)) * 64 + j) * 512 + g * 128 + c0 + e] = y;
                            }
                        }
                    }
                    __syncthreads();
                    {
                        const int c = F.tid & 127, iq = F.tid >> 7;
                        for (int i = iq; i < L; i += 4) {
                            float s = args.in[I_SGUB][(l * 4 + g) * 128 + i];
                            const float* wrow = sw + ((size_t)g * 128 + i) * 128;
                            for (int j = 0; j <= i; ++j) s += wrow[j] * vn[j * 128 + c];
                            const size_t rb = (size_t)(m0 + i) * ZP;
                            const float u = bf2f(Z[rb + CU + g * 128 + c]), gb = bf2f(Z[rb + CGB + g * 128 + c]);
                            Z[rb + CGB + g * 128 + c] = (bf16)f2bf(u * s * siluf_(gb));
                        }
                    }
                    __syncthreads();
                }
            }
            {
                constexpr int PQ = 272;
                LAS unsigned char* QT = F.lds;
                LAS unsigned char* KT = F.lds + 64 * PQ;
                LAS float* tot = (LAS float*)(F.lds + 2 * 64 * PQ);
                const int d = F.tid & 127, tg = __builtin_amdgcn_readfirstlane(F.tid >> 7);
                for (int it = F.vcu; it < 1056; it += F.G) {
                    const bool smp = it >= 1024; const int bh = smp ? it - 1024 : it >> 5, c = smp ? 0 : it & 31, bb = bh >> 2, h = bh & 3;
                    const int mb = (smp ? MP + bb * 64 : bb * SEQ) + c * 64;
                    float w2[16];
#pragma unroll
                    for (int r = 0; r < 16; ++r) w2[r] = args.in[I_WA2][(size_t)l * 16 * 512 + r * 512 + h * 128 + d];
                    const float bad = args.in[I_BA][l * 512 + h * 128 + d];
                    float bl[16], qv[16], kv[16]; float run = 0.f;
#pragma unroll
                    for (int i = 0; i < 16; ++i) {
                        const size_t m = (size_t)(mb + 16 * tg + i);
                        const float* zr = zlr + m * 16; float x = bad;
#pragma unroll
                        for (int r = 0; r < 16; ++r) x += zr[r] * w2[r];
                        const float ls = fminf(x, 0.f) - log1pf(__expf(-fabsf(x)));
                        run += ls * (1.0f / 16.0f); bl[i] = run;
                        qv[i] = bf2f(Z[m * ZP + CQ + h * 128 + d]); kv[i] = bf2f(Z[m * ZP + CK + h * 128 + d]);
                    }
                    tot[tg * 128 + d] = run;
                    asm volatile("s_waitcnt vmcnt(0)" ::: "memory");
                    __syncthreads();
                    float off = 0.f, total = 0.f;
#pragma unroll
                    for (int g2 = 0; g2 < 4; ++g2) { const float tv = tot[g2 * 128 + d]; total += tv; if (g2 < tg) off += tv; }
                    unsigned kp[8];
#pragma unroll
                    for (int i = 0; i < 16; ++i) {
                        const float b = off + bl[i]; const float eb = __expf(b);
                        const unsigned qb = f2bf(qv[i] * 0.08838834764831845f * eb), kb = f2bf(kv[i] * __expf(-b));
                        const int t = 16 * tg + i;
                        *(LAS bf16*)(QT + t * PQ + d * 2) = (bf16)qb; *(LAS bf16*)(KT + t * PQ + d * 2) = (bf16)kb;
                        Z[(size_t)(mb + t) * ZP + CQ + h * 128 + d] = (bf16)qb;
                        if (i & 1) kp[i >> 1] |= kb << 16; else kp[i >> 1] = kb;
                    }
                    {
                        bf16* kd = Z + (size_t)(mb + (d >> 1)) * ZP + CK + h * 128 + (d & 1) * 64 + 16 * tg;
                        *(v4u*)kd = (v4u){kp[0], kp[1], kp[2], kp[3]}; *(v4u*)(kd + 8) = (v4u){kp[4], kp[5], kp[6], kp[7]};
                    }
                    float* decg = (float*)(ws + WS_DEC) + (size_t)it * 128;
                    if (tg == 0) decg[d] = __expf(total);
                    __syncthreads();
                    {
                        const int lane = F.lane, rt = F.wave & 3, fr = lane & 15, fq = lane >> 4;
                        bf16* ab = (bf16*)(ws + WS_ABUF) + (size_t)it * 2560;
#pragma unroll
                        for (int cc = 0; cc < 2; ++cc) {
                            const int ct = 2 * (F.wave >> 2) + cc;
                            if (ct <= rt) {
                                pg8::f32x4 acc = {0.f, 0.f, 0.f, 0.f};
#pragma unroll
                                for (int s = 0; s < 4; ++s) {
                                    const pg8::bf16x8 kf = *(const LAS pg8::bf16x8*)(KT + (16 * ct + fr) * PQ + (32 * s + 8 * fq) * 2);
                                    const pg8::bf16x8 qf = *(const LAS pg8::bf16x8*)(QT + (16 * rt + fr) * PQ + (32 * s + 8 * fq) * 2);
                                    acc = __builtin_amdgcn_mfma_f32_16x16x32_bf16(kf, qf, acc, 0, 0, 0);
                                }
                                const int t = 16 * rt + fr, j0 = 16 * ct + 4 * fq;
                                v2u w;
                                w.x = pk2(j0 + 0 <= t ? acc[0] : 0.f, j0 + 1 <= t ? acc[1] : 0.f); w.y = pk2(j0 + 2 <= t ? acc[2] : 0.f, j0 + 3 <= t ? acc[3] : 0.f);
                                *(v2u*)(ab + (rt * (rt + 1) / 2 + ct) * 256 + fr * 16 + 4 * fq) = w;
                            }
                        }
                    }
                    __syncthreads();
                }
            }
            GRID_BAR();
        }
        if (KON(9) && IN(pb + 2)) {
        PHASE_BEGIN();
            constexpr int SB_A = 0, SB_Q = 9216, SB_KT = 26624, SB_V = 45056, SB_DEC = 50176, SB_SZ = 50688, SB_ST = 2 * SB_SZ, ST_SZ = 8704;
            constexpr int PA = 144, PQ2 = 272, PK = 144, PV = 80, PS = 272;
            const int tid = F.tid, lane = F.lane, fr = lane & 15, fq = lane >> 4;
            const int ct = F.wave & 1, rto = F.wave >> 1;
            for (int u = tid; u < 2 * SB_SZ / 16; u += 512) *(LAS v4u*)(F.lds + u * 16) = (v4u){0u, 0u, 0u, 0u};
            __syncthreads();
            for (int it = F.vcu; it < 512; it += F.G) {
                const bool smp = it >= 256; const int id = it & 255, bh = id >> 3, sl = id & 7, bb = bh >> 2, h = bh & 3;
                const int nch = smp ? 1 : 32, m0 = smp ? MP + bb * 64 : bb * SEQ, item0 = smp ? 1024 + bh : bh * 32;
                const int dvc = h * 256 + 32 * sl;
                pg8::f32x4 accS[2];
                float* sout = dout + (smp ? O_GS : O_GP) + (((size_t)l * NB + bb) * 4 + h) * 128 * 256 + 32 * sl + 16 * ct + fr;
                if (smp) {
                    const float* s0 = args.in[I_SGLA] + (((size_t)l * NB + bb) * 4 + h) * 128 * 256 + 32 * sl + 16 * ct + fr;
#pragma unroll
                    for (int k2 = 0; k2 < 2; ++k2)
#pragma unroll
                        for (int i = 0; i < 4; ++i) accS[k2][i] = s0[(size_t)(16 * (2 * rto + k2) + 4 * fq + i) * 256];
                } else { accS[0] = (pg8::f32x4){0.f, 0.f, 0.f, 0.f}; accS[1] = accS[0]; }
                v4u rA, rQ0, rQ1, rK0, rK1, rV; float rD;
                const int a_tau = tid >> 5, a_rt = (a_tau >= 6) ? 3 : (a_tau >= 3) ? 2 : (a_tau >= 1) ? 1 : 0, a_ct = a_tau - a_rt * (a_rt + 1) / 2, a_p = tid & 31;
#define SC_LOAD(cidx) do { const int mb_ = m0 + 64 * (cidx); const size_t itm_ = (size_t)(item0 + (cidx)); \
                    if (tid < 320) rA = *(const GAS v4u*)((const bf16*)(ws + WS_ABUF) + itm_ * 2560 + tid * 8); \
                    rQ0 = *(const GAS v4u*)(Z + (size_t)(mb_ + (tid >> 4)) * ZP + CQ + h * 128 + 8 * (tid & 15)); \
                    rQ1 = *(const GAS v4u*)(Z + (size_t)(mb_ + 32 + (tid >> 4)) * ZP + CQ + h * 128 + 8 * (tid & 15)); \
                    rK0 = *(const GAS v4u*)(Z + (size_t)(mb_ + (tid >> 4)) * ZP + CK + h * 128 + 8 * (tid & 15)); \
                    rK1 = *(const GAS v4u*)(Z + (size_t)(mb_ + 32 + (tid >> 4)) * ZP + CK + h * 128 + 8 * (tid & 15)); \
                    if (tid < 256) rV = *(const GAS v4u*)(Z + (size_t)(mb_ + (tid >> 2)) * ZP + CVC + dvc + 8 * (tid & 3)); \
                    if (tid < 128) rD = ((const float*)(ws + WS_DEC))[itm_ * 128 + tid]; } while (0)
#define SC_STORE(bufi) do { LAS unsigned char* B_ = F.lds + (bufi) * SB_SZ; \
                    if (tid < 320) *(LAS v4u*)(B_ + SB_A + (16 * a_rt + (a_p >> 1)) * PA + (16 * a_ct + 8 * (a_p & 1)) * 2) = rA; \
                    *(LAS v4u*)(B_ + SB_Q + (tid >> 4) * PQ2 + (tid & 15) * 16) = rQ0; *(LAS v4u*)(B_ + SB_Q + (32 + (tid >> 4)) * PQ2 + (tid & 15) * 16) = rQ1; \
                    { const int r0_ = tid >> 4, p_ = tid & 15; \
                      *(LAS v4u*)(B_ + SB_KT + (2 * r0_ + (p_ >> 3)) * PK + (p_ & 7) * 16) = rK0; *(LAS v4u*)(B_ + SB_KT + (2 * (32 + r0_) + (p_ >> 3)) * PK + (p_ & 7) * 16) = rK1; } \
                    if (tid < 256) *(LAS v4u*)(B_ + SB_V + (tid >> 2) * PV + (tid & 3) * 16) = rV; \
                    if (tid < 128) *(LAS float*)(B_ + SB_DEC + tid * 4) = rD; } while (0)
#define SC_PUBLISH(sti) do { LAS unsigned char* S_ = F.lds + SB_ST + (sti) * ST_SZ; \
                    _Pragma("unroll") for (int k2 = 0; k2 < 2; ++k2) { v2u w_; w_.x = pk2(accS[k2][0], accS[k2][1]); w_.y = pk2(accS[k2][2], accS[k2][3]); \
                        *(LAS v2u*)(S_ + (16 * ct + fr) * PS + (16 * (2 * rto + k2) + 4 * fq) * 2) = w_; } } while (0)
                SC_LOAD(0);
                SC_STORE(0);
                SC_PUBLISH(0);
                __syncthreads();
                for (int c = 0; c < nch; ++c) {
                    const int cb = c & 1;
                    if (c + 1 < nch) SC_LOAD(c + 1);
                    asm volatile("" ::: "memory");
                    LAS unsigned char* B = F.lds + cb * SB_SZ; LAS unsigned char* ST = F.lds + SB_ST + cb * ST_SZ;
                    pg8::bf16x8 vf[2];
#pragma unroll
                    for (int s = 0; s < 2; ++s) {
                        typedef short v4i16_t __attribute__((ext_vector_type(4)));
                        const int q_ = fr >> 2, p_ = lane & 3;
                        const v4i16_t lo = __builtin_amdgcn_ds_read_tr16_b64_v4i16((LAS v4i16_t*)(B + SB_V + (32 * s + 8 * fq + q_) * PV + (16 * ct + 4 * p_) * 2));
                        const v4i16_t hi = __builtin_amdgcn_ds_read_tr16_b64_v4i16((LAS v4i16_t*)(B + SB_V + (32 * s + 8 * fq + 4 + q_) * PV + (16 * ct + 4 * p_) * 2));
                        vf[s] = (pg8::bf16x8){lo[0], lo[1], lo[2], lo[3], hi[0], hi[1], hi[2], hi[3]};
                    }
                    pg8::f32x4 ao = {0.f, 0.f, 0.f, 0.f};
#pragma unroll
                    for (int s = 0; s < 2; ++s) {
                        const pg8::bf16x8 af = *(const LAS pg8::bf16x8*)(B + SB_A + (16 * rto + fr) * PA + (32 * s + 8 * fq) * 2);
                        ao = __builtin_amdgcn_mfma_f32_16x16x32_bf16(vf[s], af, ao, 0, 0, 0);
                    }
#pragma unroll
                    for (int s = 0; s < 4; ++s) {
                        const pg8::bf16x8 sf = *(const LAS pg8::bf16x8*)(ST + (16 * ct + fr) * PS + (32 * s + 8 * fq) * 2);
                        const pg8::bf16x8 qf = *(const LAS pg8::bf16x8*)(B + SB_Q + (16 * rto + fr) * PQ2 + (32 * s + 8 * fq) * 2);
                        ao = __builtin_amdgcn_mfma_f32_16x16x32_bf16(sf, qf, ao, 0, 0, 0);
                    }
                    {
                        v2u w; w.x = pk2(ao[0], ao[1]); w.y = pk2(ao[2], ao[3]);
                        *(GAS v2u*)(Z + (size_t)(m0 + 64 * c + 16 * rto + fr) * ZP + CVC + dvc + 16 * ct + 4 * fq) = w;
                    }
#pragma unroll
                    for (int k2 = 0; k2 < 2; ++k2) {
                        const int rt = 2 * rto + k2;
#pragma unroll
                        for (int s = 0; s < 2; ++s) {
                            const pg8::bf16x8 kf = *(const LAS pg8::bf16x8*)(B + SB_KT + (16 * rt + fr) * PK + (32 * s + 8 * fq) * 2);
                            accS[k2] = __builtin_amdgcn_mfma_f32_16x16x32_bf16(kf, vf[s], accS[k2], 0, 0, 0);
                        }
                        const pg8::f32x4 dc = *(const LAS pg8::f32x4*)(B + SB_DEC + (16 * rt + 4 * fq) * 4);
                        accS[k2] = accS[k2] * dc;
                    }
                    SC_PUBLISH(cb ^ 1);
                    asm volatile("" ::: "memory");
                    if (c + 1 < nch) SC_STORE(cb ^ 1);
                    __syncthreads();
                }
#pragma unroll
                for (int k2 = 0; k2 < 2; ++k2)
#pragma unroll
                    for (int i = 0; i < 4; ++i) sout[(size_t)(16 * (2 * rto + k2) + 4 * fq + i) * 256] = accS[k2][i];
#undef SC_LOAD
#undef SC_STORE
#undef SC_PUBLISH
            }
            GRID_BAR();
        }
        if (KON(4) && IN(pb + 3)) {
        PHASE_BEGIN();
            for (int it = gw; it < MT * 4; it += NGW) {
                const int m = it >> 2, h = it & 3;
                bf16* op = Z + (size_t)m * ZP + CVC + h * 256 + 4 * F.lane;
                const v2u raw = *(const GAS v2u*)op; const v2u graw = *(const GAS v2u*)(Z + (size_t)m * ZP + CGC + h * 256 + 4 * F.lane);
                float o[4] = {pg8::bflo(raw.x), pg8::bfhi(raw.x), pg8::bflo(raw.y), pg8::bfhi(raw.y)};
                const float gc[4] = {pg8::bflo(graw.x), pg8::bfhi(graw.x), pg8::bflo(graw.y), pg8::bfhi(graw.y)};
                const float ss = wave_sum((o[0] * o[0] + o[1] * o[1]) + (o[2] * o[2] + o[3] * o[3]));
                const float rstd = 1.0f / sqrtf(ss * (1.f / 256.f) + EPS);
                const f32x4 gg = *(const f32x4*)(args.in[I_GLAG] + l * 256 + 4 * F.lane);
                v2u w; w.x = pk2(o[0] * rstd * gg.x * siluf_(gc[0]), o[1] * rstd * gg.y * siluf_(gc[1])); w.y = pk2(o[2] * rstd * gg.z * siluf_(gc[2]), o[3] * rstd * gg.w * siluf_(gc[3]));
                *(GAS v2u*)op = w;
            }
            GRID_BAR();
        }
        if (KON(5) && IN(pb + 4)) {
        PHASE_BEGIN();
            pg8::Gemm g{XN, W1 + (size_t)N1A * 1024, 1024, 1024, 1024}; pg8::StaticOrder S; S.init(MT / 256, N1B / 256, F.G, (int)blockIdx.x);
            pg8::EpiGm E{Z, ZP};
            pg8::gemm_phase<pg8::EpiGm, pg8::StaticOrder, true>(F.lds, g, S, E);
            GRID_BAR();
        }
        if (KON(6) && IN(pb + 5)) {
        PHASE_BEGIN();
            pg8::Gemm g{Z + CY, (const bf16*)(ws + WS_WCAT) + (size_t)l * 1024 * 2048, ZP, 2048, 2048}; pg8::StaticOrder S; S.init(MT / 256, 4, F.G, (int)blockIdx.x);
            pg8::EpiMerge E{Z, ZP, XN, 1024};
            pg8::gemm_phase<pg8::EpiMerge, pg8::StaticOrder, true>(F.lds, g, S, E);
            GRID_BAR();
        }
        if (KON(7) && IN(pb + 6)) {
        PHASE_BEGIN();
            pg8::Gemm g{XN, (const bf16*)(ws + WS_WOUT) + (size_t)l * 1024 * 1024, 1024, 1024, 1024}; pg8::StaticOrder S; S.init(MT / 256, 4, F.G, (int)blockIdx.x);
            pg8::EpiF32 E{OUTF, 1024};
            pg8::gemm_phase<pg8::EpiF32, pg8::StaticOrder, true>(F.lds, g, S, E);
            GRID_BAR();
        }
        if (KON(8) && IN(pb + 7)) {
        PHASE_BEGIN();
            for (int m = gw; m < MT; m += NGW) {
                const float* xprev = (l == 0) ? (m < MP ? args.in[I_XP] + (size_t)m * DM : args.in[I_XS] + (size_t)(m - MP) * DM) : dout + (size_t)m * DM;
                const GAS f32x4* orow = (const GAS f32x4*)(OUTF + (size_t)m * DM) + F.lane;
                const float* modb = mod_l + (size_t)batch_of_row(m) * 3072;
                f32x4 v[4]; float s = 0.f;
#pragma unroll
                for (int j = 0; j < 4; ++j) { v[j] = orow[64 * j]; s += (v[j].x * v[j].x + v[j].y * v[j].y) + (v[j].z * v[j].z + v[j].w * v[j].w); }
                const float rstd = 1.0f / sqrtf(wave_sum(s) * (1.f / DM) + EPS);
                float s2 = 0.f;
#pragma unroll
                for (int j = 0; j < 4; ++j) {
                    const int c = 4 * F.lane + 256 * j;
                    const f32x4 pg = *(const f32x4*)(args.in[I_POSTG] + l * 1024 + c), gt = *(const f32x4*)(modb + 2048 + c), xp = *(const f32x4*)(xprev + c);
                    v[j] = xp + gt * ((v[j] * rstd) * pg);
                    *(f32x4*)(dout + (size_t)m * DM + c) = v[j];
                    s2 += (v[j].x * v[j].x + v[j].y * v[j].y) + (v[j].z * v[j].z + v[j].w * v[j].w);
                }
                if (l + 1 < DEPTH) {
                    const float rstd2 = 1.0f / sqrtf(wave_sum(s2) * (1.f / DM) + EPS);
                    const float* modn = mod_all + ((size_t)(l + 1) * 16 + batch_of_row(m)) * 3072;
                    GAS unsigned long long* o8 = (GAS unsigned long long*)(XN + (size_t)m * DM) + F.lane;
#pragma unroll
                    for (int j = 0; j < 4; ++j) {
                        const int c = 4 * F.lane + 256 * j;
                        const f32x4 gg = *(const f32x4*)(args.in[I_PREG] + (l + 1) * 1024 + c), sh = *(const f32x4*)(modn + c), sc = *(const f32x4*)(modn + 1024 + c);
                        const f32x4 hh = (v[j] * rstd2) * gg * (sc + 1.0f) + sh;
                        o8[64 * j] = (unsigned long long)pk2(hh.x, hh.y) | ((unsigned long long)pk2(hh.z, hh.w) << 32);
                    }
                }
            }
            if (l + 1 < DEPTH) GRID_BAR();
        }
    }
#undef IN
#undef GRID_BAR
}

extern "C" void kernel_launch(void* const* d_in, const int* in_sizes, int n_in, void* d_out, int out_size, void* d_ws, size_t ws_size, hipStream_t stream) {
    static int grid = 0;
    if (grid == 0) {
        if (n_in != N_IN || out_size != (int)O_END || ws_size < WS_END) { fprintf(stderr, "kernel_launch: unexpected shapes: n_in %d out %d ws %zu (need %zu)\n", n_in, out_size, ws_size, (size_t)WS_END); grid = -1; return; }
        int dev = 0, cus = 0;
        if (hipGetDevice(&dev) != hipSuccess || hipDeviceGetAttribute(&cus, hipDeviceAttributeMultiprocessorCount, dev) != hipSuccess) { grid = -1; return; }
        if (hipFuncSetAttribute((const void*)mk_fwd, hipFuncAttributeMaxDynamicSharedMemorySize, LDS_BYTES) != hipSuccess) { grid = -1; return; }
        grid = cus;
    }
    if (grid < 0) return;
    (void)hipMemsetAsync((char*)d_ws + WS_CTL, 0, CTL_ZERO_BYTES, stream);
    Args a{};
    for (int i = 0; i < N_IN; ++i) a.in[i] = (const float*)d_in[i];
    a.out = (float*)d_out; a.ws = (unsigned char*)d_ws;
#if MK_N_LAUNCHES == 1
    a.ph_lo = 0; a.ph_hi = NPH; a.li = 0;
    hipLaunchKernelGGL(mk_fwd, dim3(grid), dim3(NWAVES * 64), LDS_BYTES, stream, a);
#else
    for (int p = 0; p < NPH; ++p) { a.ph_lo = p; a.ph_hi = p + 1; a.li = p; hipLaunchKernelGGL(mk_fwd, dim3(grid), dim3(NWAVES * 64), LDS_BYTES, stream, a); }
#endif
}
```

```cpp
#include <hip/hip_runtime.h>
#include <cstdio>
#include <cstdint>

#ifndef MK_N_LAUNCHES
#define MK_N_LAUNCHES 1
#endif

namespace pg8 {
#define PG8_LAS __attribute__((address_space(3)))
typedef unsigned short bf16_t;
typedef short bf16x8 __attribute__((ext_vector_type(8)));
typedef float f32x4 __attribute__((ext_vector_type(4)));
typedef unsigned u32x4 __attribute__((ext_vector_type(4)));
constexpr int BM = 256, BK = 64, HALF = 128, HTB = HALF * BK * 2, STAGE_BYTES = 8 * HTB, NXCD = 8, WGM = 8;

__host__ __device__ __forceinline__ int lds_byte(int r, int c) { const int st = (r >> 4) * 2 + (c >> 5), rr = r & 15, cc = c & 31, ob = rr * 64 + cc * 2; return st * 1024 + (ob ^ (((ob >> 9) & 1) << 5)); }
__host__ __device__ __forceinline__ void stage_rc(int b, int& R, int& C) { const int st = b / 1024, sb = b % 1024, swz = sb ^ (((sb >> 9) & 1) << 5); R = (st >> 1) * 16 + swz / 64; C = (st & 1) * 32 + (swz % 64) / 2; }
__host__ __device__ __forceinline__ int perm32(int rho) { const int n = rho >> 4, i = rho & 15; return 8 * (i >> 2) + 4 * n + (i & 3); }

struct Unit { int pm, pn; };
struct Gemm { const bf16_t* A; const bf16_t* Bt; int lda, ldb, K; };

struct StaticOrder {
    int nM, nN, nwg, G, c;
    __host__ __device__ void init(int nM_, int nN_, int G_, int c_) { nM = nM_; nN = nN_; nwg = nM * nN; G = G_; c = c_; }
    __host__ __device__ bool next(int i, Unit& u) const {
        const long L = (long)i * G + c; if (L >= nwg) return false;
        int wgid = (int)L; { const int q = nwg / NXCD, r = nwg % NXCD, xcd = wgid % NXCD, off = wgid / NXCD; wgid = (xcd < r ? xcd * (q + 1) : r * (q + 1) + (xcd - r) * q) + off; }
        const int nig = WGM * nN, gid = wgid / nig, fm = gid * WGM, gsz = (nM - fm) < WGM ? (nM - fm) : WGM;
        u.pm = fm + ((wgid % nig) % gsz); u.pn = (wgid % nig) / gsz; return true;
    }
};

typedef float f32x2_t __attribute__((ext_vector_type(2))); typedef __bf16 bf16x2_t __attribute__((ext_vector_type(2)));
__device__ __forceinline__ unsigned cvt_pk_bf16(float lo, float hi) { f32x2_t v = {lo, hi}; bf16x2_t b = __builtin_convertvector(v, bf16x2_t); return __builtin_bit_cast(unsigned, b); }
__device__ __forceinline__ float bflo(unsigned w) { return __uint_as_float(w << 16); }
__device__ __forceinline__ float bfhi(unsigned w) { return __uint_as_float(w & 0xffff0000u); }
__device__ __forceinline__ float sigmoidf_(float x) { return __builtin_amdgcn_rcpf(1.0f + __builtin_amdgcn_exp2f(-1.4426950408889634f * x)); }

struct EpiZ {
    static constexpr bool PERM = true, AFTER_DRAIN = false, KHOOK = false;
    bf16_t* Z; int ldz; float* pool_p; float* pool_s;
    __device__ __forceinline__ void operator()(const f32x4 (&acc)[2][2][4][2], const Unit& u, int wr, int wc, int fr, int fq) const {
        const int row0 = u.pm * BM + wr * 64 + fr, col0 = u.pn * BM + wc * 32 + 8 * fq;
#pragma unroll
        for (int ai = 0; ai < 2; ++ai)
#pragma unroll
            for (int m = 0; m < 4; ++m) {
                const int r = row0 + ai * HALF + m * 16; bf16_t* rowp = Z + (size_t)r * ldz + col0;
                float* prow = nullptr;
                if (u.pn < 2) {
                    if (r < 16384) { const int t = r & 2047; if (t >= 2033) prow = pool_p + (size_t)((r >> 11) * 15 + (t - 2033)) * 512; }
                    else { const int rs = r - 16384, t = rs & 63; if (t >= 49) prow = pool_s + (size_t)((rs >> 6) * 15 + (t - 49)) * 512; }
                }
#pragma unroll
                for (int bj = 0; bj < 2; ++bj) {
                    const f32x4 v0 = acc[ai][bj][m][0], v1 = acc[ai][bj][m][1];
                    u32x4 w; w.x = cvt_pk_bf16(v0[0], v0[1]); w.y = cvt_pk_bf16(v0[2], v0[3]); w.z = cvt_pk_bf16(v1[0], v1[1]); w.w = cvt_pk_bf16(v1[2], v1[3]);
                    *(u32x4*)(rowp + bj * HALF) = w;
                    if (prow) { *(f32x4*)(prow + col0 + bj * HALF) = v0; *(f32x4*)(prow + col0 + bj * HALF + 4) = v1; }
                }
            }
    }
};
struct EpiGm {
    static constexpr bool PERM = true, AFTER_DRAIN = false, KHOOK = false;
    bf16_t* Z; int ldz;
    __device__ __forceinline__ void operator()(const f32x4 (&acc)[2][2][4][2], const Unit& u, int wr, int wc, int fr, int fq) const {
        const int row0 = u.pm * BM + wr * 64 + fr, col0 = u.pn * BM + wc * 32 + 8 * fq;
#pragma unroll
        for (int ai = 0; ai < 2; ++ai)
#pragma unroll
            for (int m = 0; m < 4; ++m) {
                bf16_t* rowp = Z + (size_t)(row0 + ai * HALF + m * 16) * ldz + col0;
#pragma unroll
                for (int bj = 0; bj < 2; ++bj) {
                    const f32x4 v0 = acc[ai][bj][m][0], v1 = acc[ai][bj][m][1];
                    u32x4 w; w.x = cvt_pk_bf16(sigmoidf_(v0[0]), sigmoidf_(v0[1])); w.y = cvt_pk_bf16(sigmoidf_(v0[2]), sigmoidf_(v0[3]));
                    w.z = cvt_pk_bf16(sigmoidf_(v1[0]), sigmoidf_(v1[1])); w.w = cvt_pk_bf16(sigmoidf_(v1[2]), sigmoidf_(v1[3]));
                    *(u32x4*)(rowp + bj * HALF) = w;
                }
            }
    }
};
struct EpiMerge {
    static constexpr bool PERM = true, AFTER_DRAIN = false, KHOOK = true;
    const bf16_t* G; int ldg; bf16_t* Mo; int ldm;
    __device__ __forceinline__ void khook(f32x4 (&acc)[2][2][4][2], const Unit& u, int t, int wr, int wc, int fr, int fq) const {
        if (t != 8 && t != 16) return;
        const int br = (t == 8) ? 0 : 1;
        asm volatile("" : "+v"(fr), "+v"(fq));
        const int row0 = u.pm * BM + wr * 64 + fr, col0 = u.pn * BM + wc * 32 + 8 * fq;
#pragma unroll
        for (int ai = 0; ai < 2; ++ai)
#pragma unroll
            for (int m = 0; m < 4; ++m) {
                const bf16_t* gp = G + (size_t)(row0 + ai * HALF + m * 16) * ldg + br * 1024 + col0;
#pragma unroll
                for (int bj = 0; bj < 2; ++bj) {
                    const u32x4 nu = *(const u32x4*)(gp + bj * HALF), de = *(const u32x4*)(gp + 1024 + bj * HALF);
                    f32x4 r0, r1;
                    r0[0] = bflo(nu.x) * __builtin_amdgcn_rcpf(bflo(de.x)); r0[1] = bfhi(nu.x) * __builtin_amdgcn_rcpf(bfhi(de.x));
                    r0[2] = bflo(nu.y) * __builtin_amdgcn_rcpf(bflo(de.y)); r0[3] = bfhi(nu.y) * __builtin_amdgcn_rcpf(bfhi(de.y));
                    r1[0] = bflo(nu.z) * __builtin_amdgcn_rcpf(bflo(de.z)); r1[1] = bfhi(nu.z) * __builtin_amdgcn_rcpf(bfhi(de.z));
                    r1[2] = bflo(nu.w) * __builtin_amdgcn_rcpf(bflo(de.w)); r1[3] = bfhi(nu.w) * __builtin_amdgcn_rcpf(bfhi(de.w));
                    acc[ai][bj][m][0] *= r0; acc[ai][bj][m][1] *= r1;
                }
                asm volatile("" ::: "memory");
            }
    }
    __device__ __forceinline__ void operator()(const f32x4 (&acc)[2][2][4][2], const Unit& u, int wr, int wc, int fr, int fq) const {
        const int row0 = u.pm * BM + wr * 64 + fr, col0 = u.pn * BM + wc * 32 + 8 * fq;
#pragma unroll
        for (int ai = 0; ai < 2; ++ai)
#pragma unroll
            for (int m = 0; m < 4; ++m) {
                const int r = row0 + ai * HALF + m * 16;
                const bf16_t* gp = G + (size_t)r * ldg + 2048 + col0; bf16_t* rowp = Mo + (size_t)r * ldm + col0;
#pragma unroll
                for (int bj = 0; bj < 2; ++bj) {
                    const u32x4 g = *(const u32x4*)(gp + bj * HALF);
                    const f32x4 v0 = acc[ai][bj][m][0], v1 = acc[ai][bj][m][1];
                    u32x4 w; w.x = cvt_pk_bf16(v0[0] * bflo(g.x), v0[1] * bfhi(g.x)); w.y = cvt_pk_bf16(v0[2] * bflo(g.y), v0[3] * bfhi(g.y));
                    w.z = cvt_pk_bf16(v1[0] * bflo(g.z), v1[1] * bfhi(g.z)); w.w = cvt_pk_bf16(v1[2] * bflo(g.w), v1[3] * bfhi(g.w));
                    *(u32x4*)(rowp + bj * HALF) = w;
                }
            }
    }
};
struct EpiF32 {
    static constexpr bool PERM = false, AFTER_DRAIN = false, KHOOK = false;
    float* C; int ldc;
    __device__ __forceinline__ void operator()(const f32x4 (&acc)[2][2][4][2], const Unit& u, int wr, int wc, int fr, int fq) const {
        const int row0 = u.pm * BM + wr * 64 + fr, col0 = u.pn * BM + wc * 32 + 4 * fq;
#pragma unroll
        for (int ai = 0; ai < 2; ++ai)
#pragma unroll
            for (int m = 0; m < 4; ++m) { float* rowp = C + (size_t)(row0 + ai * HALF + m * 16) * ldc + col0;
#pragma unroll
                for (int bj = 0; bj < 2; ++bj)
#pragma unroll
                    for (int n = 0; n < 2; ++n) *(f32x4*)(rowp + bj * HALF + n * 16) = acc[ai][bj][m][n]; }
    }
};

template <class Epi, class Sched, bool ALIGN_EPI>
__device__ __forceinline__ void gemm_phase(PG8_LAS unsigned char* lds, const Gemm g, const Sched& S, const Epi& E) {
    int tid_ = threadIdx.x; asm volatile("" : "+v"(tid_));
    const int tid = tid_, wid = __builtin_amdgcn_readfirstlane(tid >> 6), lane = tid & 63, wr = wid >> 2, wc = wid & 3, fr = lane & 15, fq = lane >> 4;
    const int K = g.K, nt = K / BK;
    unsigned voffA[2], voffB[2];
#pragma unroll
    for (int i = 0; i < 2; ++i) { int R, C; stage_rc(tid * 16 + i * 8192, R, C); const int Rb = Epi::PERM ? ((R & ~31) + perm32(R & 31)) : R;
        voffA[i] = (unsigned)(R * g.lda + C) * 2u; voffB[i] = (unsigned)(Rb * g.ldb + C) * 2u; }
    const size_t kstep = (size_t)(BK * 2);
    const size_t hstepA = (size_t)HALF * g.lda * 2, hstepB = (size_t)HALF * g.ldb * 2;
    const size_t tstepA = 2 * hstepA, tstepB = 2 * hstepB;
    const unsigned ldsw = (unsigned)wid * 1024u;
    const int aoff = lds_byte(wr * 64 + fr, fq * 8), boff = lds_byte(wc * 32 + fr, fq * 8);
#define PG8_SA(b, h) (((b) * 2 + (h)) * HTB)
#define PG8_SB(b, h) ((4 + (b) * 2 + (h)) * HTB)
#define PG8_STAGE(bufoff, gbase, voff) do { _Pragma("unroll") for (int _i = 0; _i < 2; ++_i) \
        __builtin_amdgcn_global_load_lds((const unsigned*)((const char*)(gbase) + (voff)[_i]), (PG8_LAS unsigned*)(lds + (bufoff) + ldsw + _i * 8192), 16, 0, 0); } while (0)
#define PG8_LDA(dst, b, h) do { _Pragma("unroll") for (int m = 0; m < 4; ++m) _Pragma("unroll") for (int k = 0; k < 2; ++k) dst[m][k] = *(const PG8_LAS bf16x8*)(lds + PG8_SA(b, h) + aoff + m * 2048 + k * 1024); } while (0)
#define PG8_LDB(dst, b, h) do { _Pragma("unroll") for (int n = 0; n < 2; ++n) _Pragma("unroll") for (int k = 0; k < 2; ++k) dst[n][k] = *(const PG8_LAS bf16x8*)(lds + PG8_SB(b, h) + boff + n * 2048 + k * 1024); } while (0)
#define PG8_MMA(ai, bj, At, Bt) do { __builtin_amdgcn_s_setprio(1); _Pragma("unroll") for (int m = 0; m < 4; ++m) _Pragma("unroll") for (int n = 0; n < 2; ++n) _Pragma("unroll") for (int k = 0; k < 2; ++k) \
        acc[ai][bj][m][n] = __builtin_amdgcn_mfma_f32_16x16x32_bf16(Bt[n][k], At[m][k], acc[ai][bj][m][n], 0, 0, 0); __builtin_amdgcn_s_setprio(0); } while (0)
#define PG8_WAIT_V(n) asm volatile("s_waitcnt vmcnt(" #n ")" ::: "memory")
#define PG8_WAIT_L(n) asm volatile("s_waitcnt lgkmcnt(" #n ")" ::: "memory")
#define PG8_BAR __builtin_amdgcn_s_barrier()
#define PG8_SCHED __builtin_amdgcn_sched_barrier(0)
    Unit cur, nxt; int ui = 0;
    if (!S.next(0, cur)) return;
    f32x4 acc[2][2][4][2];
#pragma unroll
    for (int a = 0; a < 2; ++a)
#pragma unroll
        for (int b = 0; b < 2; ++b)
#pragma unroll
            for (int m = 0; m < 4; ++m)
#pragma unroll
                for (int n = 0; n < 2; ++n) acc[a][b][m][n] = (f32x4){0.f, 0.f, 0.f, 0.f};
    bf16x8 At[4][2], B0[2][2], B1[2][2];
    const char* cA = (const char*)g.A + (size_t)cur.pm * tstepA; const char* cB = (const char*)g.Bt + (size_t)cur.pn * tstepB;
    PG8_STAGE(PG8_SB(0, 0), cB, voffB); PG8_STAGE(PG8_SB(0, 1), cB + hstepB, voffB); PG8_STAGE(PG8_SA(0, 0), cA, voffA); PG8_STAGE(PG8_SA(0, 1), cA + hstepA, voffA);
    if (wr == 1) PG8_BAR;
    PG8_WAIT_V(2); PG8_BAR;
    PG8_STAGE(PG8_SB(1, 0), cB + kstep, voffB); PG8_STAGE(PG8_SA(1, 0), cA + kstep, voffA); PG8_STAGE(PG8_SB(1, 1), cB + hstepB + kstep, voffB);
    PG8_WAIT_V(6); PG8_BAR;
    for (;;) {
        const bool has_next = S.next(ui + 1, nxt);
        const char* nA = has_next ? (const char*)g.A + (size_t)nxt.pm * tstepA : cA; const char* nB = has_next ? (const char*)g.Bt + (size_t)nxt.pn * tstepB : cB;
        for (int t = 0; t < nt; t += 2) {
            const bool last = (t == nt - 2);
            const char* a1 = cA + (size_t)(t + 1) * kstep;
            const char* a2 = last ? nA : cA + (size_t)(t + 2) * kstep; const char* b2 = last ? nB : cB + (size_t)(t + 2) * kstep;
            const char* a3 = a2 + kstep; const char* b3 = b2 + kstep;
            if constexpr (Epi::KHOOK) E.khook(acc, cur, t, wr, wc, fr, fq);
            PG8_LDB(B0, 0, 0); PG8_LDB(B1, 0, 1); PG8_SCHED; PG8_LDA(At, 0, 0); PG8_STAGE(PG8_SA(1, 1), a1 + hstepA, voffA);
            PG8_WAIT_V(8); PG8_WAIT_L(0); PG8_BAR; PG8_MMA(0, 0, At, B0); PG8_MMA(0, 1, At, B1); PG8_BAR; PG8_SCHED;
            PG8_LDA(At, 0, 1); PG8_STAGE(PG8_SB(0, 0), b2, voffB); PG8_STAGE(PG8_SB(0, 1), b2 + hstepB, voffB); PG8_STAGE(PG8_SA(0, 0), a2, voffA);
            PG8_WAIT_V(8); PG8_WAIT_L(0); PG8_BAR; PG8_MMA(1, 0, At, B0); PG8_MMA(1, 1, At, B1); PG8_BAR; PG8_SCHED;
            PG8_LDB(B0, 1, 0); PG8_LDB(B1, 1, 1); PG8_SCHED; PG8_LDA(At, 1, 0); PG8_STAGE(PG8_SA(0, 1), a2 + hstepA, voffA);
            PG8_WAIT_V(8); PG8_WAIT_L(0); PG8_BAR; PG8_MMA(0, 0, At, B0); PG8_MMA(0, 1, At, B1); PG8_BAR; PG8_SCHED;
            PG8_LDA(At, 1, 1); PG8_STAGE(PG8_SB(1, 0), b3, voffB); PG8_STAGE(PG8_SB(1, 1), b3 + hstepB, voffB); PG8_STAGE(PG8_SA(1, 0), a3, voffA);
            PG8_WAIT_V(8); PG8_WAIT_L(0); PG8_BAR; PG8_MMA(1, 0, At, B0); PG8_MMA(1, 1, At, B1); PG8_BAR; PG8_SCHED;
        }
        if constexpr (ALIGN_EPI) { if (wr == 0) PG8_BAR; }
        E(acc, cur, wr, wc, fr, fq);
        if (!has_next) break;
#pragma unroll
        for (int a = 0; a < 2; ++a)
#pragma unroll
            for (int b = 0; b < 2; ++b)
#pragma unroll
                for (int m = 0; m < 4; ++m)
#pragma unroll
                    for (int n = 0; n < 2; ++n) acc[a][b][m][n] = (f32x4){0.f, 0.f, 0.f, 0.f};
        cur = nxt; cA = nA; cB = nB; ++ui;
        if constexpr (ALIGN_EPI) { if (wr == 1) PG8_BAR; }
    }
    PG8_WAIT_V(0);
    if constexpr (!ALIGN_EPI) { if (wr == 0) PG8_BAR; }
    PG8_BAR;
#undef PG8_SA
#undef PG8_SB
#undef PG8_STAGE
#undef PG8_LDA
#undef PG8_LDB
#undef PG8_MMA
#undef PG8_WAIT_V
#undef PG8_WAIT_L
#undef PG8_BAR
#undef PG8_SCHED
}
}

constexpr int NWAVES = 8;
constexpr int DM = 1024, MP = 16384, MS = 512, MT = MP + MS;
constexpr int SEQ = 2048, DSEQ = 64, DEPTH = 2, NB = 8;
constexpr int D_IN = 8720;
constexpr int ZP = 5632;
constexpr int CA = 0, CU = 512, CVB = 1024, CQ = 1536, CK = 2048, CGC = 2560, CGA = 3584, CGB = 4096, CVC = 4608, CY = 3584;
constexpr int N1A = 5632, N1B = 3072, N1 = N1A + N1B;
constexpr float EPS = 1e-6f;
constexpr size_t O_YP = 0, O_YS = 16777216, O_PP = 17301504, O_GP = 17424384, O_PS = 19521536, O_GS = 19644416, O_SV = 21741568, O_END = 22265856;

constexpr size_t MiB = 1u << 20;
constexpr size_t WS_CTL = 0, CTL_ZERO_BYTES = 64 * 1024;
constexpr size_t WS_MOD = 1 * MiB;
constexpr size_t WS_SGUW = 1 * MiB + 512 * 1024;
constexpr size_t WS_PWT = 1 * MiB + 768 * 1024;
constexpr size_t WS_ZLR = 2 * MiB;
constexpr size_t WS_WLR = 3 * MiB + 512 * 1024;
constexpr size_t WS_WLRB = 3 * MiB + 640 * 1024;
constexpr size_t WS_W1 = 4 * MiB;
constexpr size_t WS_WCAT = 38 * MiB;
constexpr size_t WS_WOUT = 46 * MiB;
constexpr size_t WS_XN = 50 * MiB;
constexpr size_t WS_Z = 83 * MiB;
constexpr size_t WS_ABUF = WS_Z + (size_t)MT * ZP * 2;
constexpr size_t WS_DEC = WS_ABUF + (size_t)1056 * 5120;
constexpr size_t WS_END = WS_DEC + (size_t)1056 * 512;
static_assert(WS_ZLR + (size_t)MT * 16 * 4 <= WS_WLR && WS_W1 + (size_t)2 * N1 * 1024 * 2 <= WS_WCAT && WS_WCAT + (size_t)2 * 1024 * 2048 * 2 <= WS_WOUT && WS_WOUT + (size_t)2 * 1024 * 1024 * 2 <= WS_XN && WS_XN + (size_t)MT * 1024 * 2 <= WS_Z, "ws map");
constexpr int CW_TMO = 0, CW_BAR = 4096;

constexpr int RING_BYTES = 131072, LDSCTL_OFF = RING_BYTES, MISC_OFF = LDSCTL_OFF + 320, LDS_BYTES = 147456;

#define GAS __attribute__((address_space(1)))
#define LAS __attribute__((address_space(3)))
typedef unsigned short bf16;
typedef unsigned v4u __attribute__((ext_vector_type(4)));
typedef unsigned v2u __attribute__((ext_vector_type(2)));
typedef float f32x4 __attribute__((ext_vector_type(4)));
typedef GAS unsigned gu32;
#define RLX_AGENT __ATOMIC_RELAXED, __HIP_MEMORY_SCOPE_AGENT
#define LDS_WAIT() asm volatile("s_waitcnt lgkmcnt(0)" ::: "memory")
__device__ __forceinline__ unsigned f2bf(float f) { unsigned u = __builtin_bit_cast(unsigned, f); return (u + 0x7fffu + ((u >> 16) & 1u)) >> 16; }
__device__ __forceinline__ unsigned pk2(float lo, float hi) { return f2bf(lo) | (f2bf(hi) << 16); }
__device__ __forceinline__ float bf2f(bf16 v) { return __uint_as_float((unsigned)v << 16); }
__device__ __forceinline__ float siluf_(float x) { return x * __builtin_amdgcn_rcpf(1.0f + __expf(-x)); }

#define XB_TMO      128
#define XB_XCNT(j)  (256  + 64 * (j))
#define XB_XSUB(j)  (1280 + 64 * (j))
#define XB_XGEN(j)  (2304 + 64 * (j))
#define XB_TOP      3328
#define XB_TOPGEN   3392
#define XCD_BAR_WORDS 3456
#define XB_SPIN_CAP (1u << 18)
__device__ __forceinline__ unsigned xb_ld(unsigned* p)              { return __hip_atomic_load(p, __ATOMIC_RELAXED, __HIP_MEMORY_SCOPE_AGENT); }
__device__ __forceinline__ unsigned xb_add(unsigned* p, unsigned v) { return __hip_atomic_fetch_add(p, v, __ATOMIC_RELAXED, __HIP_MEMORY_SCOPE_AGENT); }
__device__ __forceinline__ unsigned xb_xcc_id() { return (unsigned)__builtin_amdgcn_s_getreg((3 << 11) | 20) & 0xFu; }
#define XB_SPIN(cond, bar) do { unsigned _sp = 0; while (cond) { __builtin_amdgcn_s_sleep(1); \
    if ((++_sp & 255u) == 0u) { if (xb_ld(&(bar)[XB_TMO])) break; if (_sp > XB_SPIN_CAP) { atomicAdd(&(bar)[XB_TMO], 1u); break; } } } } while (0)
struct XcdBarrier { unsigned* bar; unsigned x; volatile LAS unsigned* st; };
__device__ __forceinline__ XcdBarrier xcd_barrier_post(unsigned* bar, volatile LAS unsigned* st) {
    XcdBarrier b; b.bar = bar; b.x = xb_xcc_id(); b.st = st;
    if (threadIdx.x == 0) (void)xb_add(&bar[XB_XCNT(b.x)], 1u);
    return b;
}
__device__ __forceinline__ void xcd_barrier_complete(unsigned* bar, unsigned x, unsigned& nloc, unsigned& nx) {
    const unsigned G = gridDim.x * gridDim.y * gridDim.z;
    unsigned sum, cnt, mine, sp = 0u;
    for (;;) {
        sum = 0u; cnt = 0u; mine = 0u;
#pragma unroll
        for (unsigned j = 0; j < 16; ++j) { const unsigned c = xb_ld(&bar[XB_XCNT(j)]); sum += c; cnt += (c > 0u) ? 1u : 0u; mine = (j == x) ? c : mine; }
        if (sum == G) break;
        __builtin_amdgcn_s_sleep(1);
        if ((++sp & 255u) == 0u) { if (xb_ld(&bar[XB_TMO])) break; if (sp > XB_SPIN_CAP) { atomicAdd(&bar[XB_TMO], 1u); break; } }
    }
    nloc = mine > 0u ? mine : 1u; nx = cnt > 0u ? cnt : 1u;
}
__device__ __forceinline__ void xcd_barrier(const XcdBarrier& b) {
    asm volatile("s_waitcnt vmcnt(0)" ::: "memory");
    __syncthreads();
    if (threadIdx.x == 0) {
        unsigned* bar = b.bar;
        __builtin_amdgcn_s_waitcnt(0);
        unsigned nloc = b.st[0], nx = b.st[1];
        if (nloc == 0u) { xcd_barrier_complete(bar, b.x, nloc, nx); b.st[0] = nloc; b.st[1] = nx; }
        const unsigned old = xb_add(&bar[XB_XSUB(b.x)], 1u);
        const unsigned gen = old / nloc;
        if (old + 1u == (gen + 1u) * nloc) {
            __builtin_amdgcn_fence(__ATOMIC_RELEASE, "agent");
            asm volatile("s_waitcnt vmcnt(0)" ::: "memory");
            const unsigned og = xb_add(&bar[XB_TOP], 1u);
            const unsigned tg = og / nx;
            if (og + 1u == (tg + 1u) * nx) xb_add(&bar[XB_TOPGEN], 1u);
            else XB_SPIN(xb_ld(&bar[XB_TOPGEN]) == tg, bar);
            __builtin_amdgcn_fence(__ATOMIC_ACQUIRE, "agent");
            xb_add(&bar[XB_XGEN(b.x)], 1u);
            asm volatile("s_waitcnt vmcnt(0)" ::: "memory");
        } else {
            XB_SPIN(xb_ld(&bar[XB_XGEN(b.x)]) == gen, bar);
            __builtin_amdgcn_fence(__ATOMIC_ACQUIRE, "agent");
            asm volatile("s_waitcnt vmcnt(0)" ::: "memory");
        }
    }
    __syncthreads();
}

__device__ __forceinline__ int opq(int x) { asm volatile("" : "+v"(x)); return x; }
struct Frame {
    LAS unsigned char* lds;
    int tid, lane, wave, vcu, G;
};
__device__ __forceinline__ float wave_sum(float v) {
    v += __int_as_float(__builtin_amdgcn_ds_swizzle(__float_as_int(v), 0x041F));
    v += __int_as_float(__builtin_amdgcn_ds_swizzle(__float_as_int(v), 0x081F));
    v += __int_as_float(__builtin_amdgcn_ds_swizzle(__float_as_int(v), 0x101F));
    v += __int_as_float(__builtin_amdgcn_ds_swizzle(__float_as_int(v), 0x201F));
    v += __int_as_float(__builtin_amdgcn_ds_swizzle(__float_as_int(v), 0x401F));
    const auto rr = __builtin_amdgcn_permlane32_swap(__float_as_uint(v), __float_as_uint(v), false, false);
    return __uint_as_float(rr[0]) + __uint_as_float(rr[1]);
}
enum { I_XP = 0, I_XS, I_SPOOL, I_SGLA, I_CP, I_CS, I_ADAW, I_ADAB, I_PREG, I_POSTG, I_WIN, I_POOLW, I_POOLS, I_SGUG, I_SGUW, I_SGUB, I_WA2, I_BA, I_GLAG, I_WOA, I_WOB, I_WOC, I_WOUT, N_IN };
struct Args { const float* in[N_IN]; float* out; unsigned char* ws; int ph_lo, ph_hi, li, pad; };

__device__ __forceinline__ void transpose_item(const float* src, int ldsrc, bf16* dst, int ldd, LAS float* scr, int lane) {
#pragma unroll 8
    for (int i = 0; i < 32; ++i) { const int kk = 2 * i + (lane >> 5); scr[kk * 33 + (lane & 31)] = src[(size_t)kk * ldsrc + (lane & 31)]; }
    LDS_WAIT(); asm volatile("" ::: "memory");
    const int c = lane & 7;
#pragma unroll
    for (int j = 0; j < 4; ++j) { const int n = (lane >> 3) + 8 * j; const LAS float* s = scr + (8 * c) * 33 + n;
        v4u o; o.x = pk2(s[0 * 33], s[1 * 33]); o.y = pk2(s[2 * 33], s[3 * 33]); o.z = pk2(s[4 * 33], s[5 * 33]); o.w = pk2(s[6 * 33], s[7 * 33]);
        *(GAS v4u*)(dst + (size_t)n * ldd + 8 * c) = o; }
    LDS_WAIT(); asm volatile("" ::: "memory");
}
__device__ __forceinline__ int w1_src_col(int n) {
    if (n < 512) return n;
    if (n < 1024) return 1024 + (n - 512);
    if (n < 1536) return 1536 + (n - 1024);
    if (n < 2048) return 2560 + (n - 1536);
    if (n < 2560) return 3072 + (n - 2048);
    if (n < 3584) return 4608 + (n - 2560);
    if (n < 4096) return 512 + (n - 3584);
    if (n < 4608) return 2048 + (n - 4096);
    if (n < 5632) return 3584 + (n - 4608);
    return 5648 + (n - 5632);
}
__device__ __forceinline__ int batch_of_row(int m) { return m < MP ? (m >> 11) : 8 + ((m - MP) >> 6); }

__device__ __forceinline__ void xn_row(const float* xrow, const float* g, const float* mod  , bf16* orow, int lane) {
    const GAS f32x4* xr = (const GAS f32x4*)xrow + lane;
    f32x4 v[4]; float s = 0.f;
#pragma unroll
    for (int j = 0; j < 4; ++j) { v[j] = xr[64 * j]; s += (v[j].x * v[j].x + v[j].y * v[j].y) + (v[j].z * v[j].z + v[j].w * v[j].w); }
    const float rstd = 1.0f / sqrtf(wave_sum(s) * (1.f / DM) + EPS);
    GAS unsigned long long* o8 = (GAS unsigned long long*)orow + lane;
#pragma unroll
    for (int j = 0; j < 4; ++j) {
        const int c = 4 * lane + 256 * j;
        const f32x4 gg = *(const f32x4*)(g + c), sh = *(const f32x4*)(mod + c), sc = *(const f32x4*)(mod + 1024 + c);
        const f32x4 h = (v[j] * rstd) * gg * (sc + 1.0f) + sh;
        o8[64 * j] = (unsigned long long)pk2(h.x, h.y) | ((unsigned long long)pk2(h.z, h.w) << 32);
    }
}

constexpr int NPH = 18;

__global__ void __launch_bounds__(NWAVES * 64, 2) mk_fwd(Args args) {
    extern __shared__ __attribute__((aligned(16))) unsigned char lds[];
    Frame F;
    F.lds = (LAS unsigned char*)lds;
    volatile LAS unsigned* MISC = (volatile LAS unsigned*)(F.lds + MISC_OFF);
    F.tid = threadIdx.x; F.lane = F.tid & 63; F.wave = __builtin_amdgcn_readfirstlane(F.tid >> 6);
    F.G = gridDim.x; { const int bx = blockIdx.x; F.vcu = (F.G % 8 == 0) ? (bx % 8) * (F.G / 8) + bx / 8 : bx; }
    unsigned char* ws = args.ws;
    gu32* ctl = (gu32*)(ws + WS_CTL);
    for (int u = F.tid; u < (LDS_BYTES - LDSCTL_OFF) / 4; u += NWAVES * 64) ((LAS unsigned*)(F.lds + LDSCTL_OFF))[u] = 0u;
    __syncthreads();
    XcdBarrier bar; bar.bar = (unsigned*)(ctl + CW_BAR); bar.x = 0; bar.st = nullptr;
    if (MK_N_LAUNCHES == 1) bar = xcd_barrier_post((unsigned*)(ctl + CW_BAR), MISC + 8);
#define GRID_BAR() do { if (MK_N_LAUNCHES == 1) xcd_barrier(bar); } while (0)
    const int lo = args.ph_lo, hi = args.ph_hi;
#ifndef ABLMASK
#define ABLMASK 0xffff
#endif
#define IN(k) (lo <= (k) && (k) < hi)
#define PHASE_BEGIN() do { F.tid = opq((int)threadIdx.x); F.lane = F.tid & 63; } while (0)
#define KON(b) ((ABLMASK >> (b)) & 1)
    float* mod_all = (float*)(ws + WS_MOD);
    float* zlr = (float*)(ws + WS_ZLR);
    float* wlr_all = (float*)(ws + WS_WLR);
    bf16* XN = (bf16*)(ws + WS_XN);
    bf16* Z = (bf16*)(ws + WS_Z);
    float* OUTF = (float*)(ws + WS_Z);
    float* dout = args.out;
    const int gw = F.vcu * NWAVES + F.wave, NGW = F.G * NWAVES;

    if (KON(0) && IN(0)) {
        PHASE_BEGIN();
        LAS float* scr = (LAS float*)(F.lds + F.wave * 16384);
        constexpr int I_W1 = (1024 / 64) * (N1 / 32);
        constexpr int I_OA = (512 / 64) * 32, I_OC = (1024 / 64) * 32, I_OUT = (1024 / 64) * 32;
        constexpr int PER_L = I_W1 + 2 * I_OA + I_OC + I_OUT;
        for (int it = gw; it < 2 * PER_L; it += NGW) {
            const int l = it / PER_L; int r = it % PER_L;
            if (r < I_W1) { const int nb = r % (N1 / 32), kb = r / (N1 / 32); const int n0 = 32 * nb, k0 = 64 * kb;
                transpose_item(args.in[I_WIN] + (size_t)l * 1024 * D_IN + (size_t)k0 * D_IN + w1_src_col(n0), D_IN, (bf16*)(ws + WS_W1) + ((size_t)l * N1 + n0) * 1024 + k0, 1024, scr, F.lane); continue; }
            r -= I_W1;
            bf16* wcat = (bf16*)(ws + WS_WCAT) + (size_t)l * 1024 * 2048;
            if (r < I_OA) { const int nb = r % 32, kb = r / 32; transpose_item(args.in[I_WOA] + (size_t)l * 512 * 1024 + (size_t)(64 * kb) * 1024 + 32 * nb, 1024, wcat + (size_t)(32 * nb) * 2048 + 64 * kb, 2048, scr, F.lane); continue; }
            r -= I_OA;
            if (r < I_OA) { const int nb = r % 32, kb = r / 32; transpose_item(args.in[I_WOB] + (size_t)l * 512 * 1024 + (size_t)(64 * kb) * 1024 + 32 * nb, 1024, wcat + (size_t)(32 * nb) * 2048 + 512 + 64 * kb, 2048, scr, F.lane); continue; }
            r -= I_OA;
            if (r < I_OC) { const int nb = r % 32, kb = r / 32; transpose_item(args.in[I_WOC] + (size_t)l * 1024 * 1024 + (size_t)(64 * kb) * 1024 + 32 * nb, 1024, wcat + (size_t)(32 * nb) * 2048 + 1024 + 64 * kb, 2048, scr, F.lane); continue; }
            r -= I_OC;
            { const int nb = r % 32, kb = r / 32; transpose_item(args.in[I_WOUT] + (size_t)l * 1024 * 1024 + (size_t)(64 * kb) * 1024 + 32 * nb, 1024, (bf16*)(ws + WS_WOUT) + (size_t)l * 1024 * 1024 + (size_t)(32 * nb) * 1024 + 64 * kb, 1024, scr, F.lane); }
        }
        for (int i = blockIdx.x * 512 + F.tid; i < 2 * 4 * 128 * 128; i += F.G * 512) {
            const int jj = i & 127, ii = (i >> 7) & 127, lg = i >> 14;
            ((bf16*)(ws + WS_SGUW))[i] = (bf16)f2bf(jj <= ii ? args.in[I_SGUW][i] : 0.f);
            ((bf16*)(ws + WS_PWT))[i] = (bf16)f2bf(args.in[I_POOLW][(size_t)lg * 16384 + jj * 128 + ii]);
        }
        for (int i = blockIdx.x * 512 + F.tid; i < 2 * 16 * 1024; i += F.G * 512) { const int l = i >> 14, r = (i >> 10) & 15, k = i & 1023; ((bf16*)(ws + WS_WLRB))[i] = (bf16)f2bf(args.in[I_WIN][(size_t)l * 1024 * D_IN + (size_t)k * D_IN + 5632 + r]); }
        for (int i = blockIdx.x * 512 + F.tid; i < 2 * 16 * 1024; i += F.G * 512) { const int l = i >> 14, r = (i >> 10) & 15, k = i & 1023; wlr_all[i] = args.in[I_WIN][(size_t)l * 1024 * D_IN + (size_t)k * D_IN + 5632 + r]; }
        __syncthreads();
        LAS float* sc = (LAS float*)F.lds;
        LAS float* part = (LAS float*)(F.lds + 65536);
        for (int it = F.vcu; it < 2 * 48; it += F.G) {
            const int l = it / 48, j0 = (it % 48) * 64;
            for (int i = F.tid; i < 16 * 1024; i += 512) { const int bi = i >> 10, k = i & 1023; const float cv = bi < 8 ? args.in[I_CP][bi * 1024 + k] : args.in[I_CS][(bi - 8) * 1024 + k]; sc[i] = siluf_(cv); }
            __syncthreads();
            float a[16];
#pragma unroll
            for (int b = 0; b < 16; ++b) a[b] = 0.f;
            const float* wp = args.in[I_ADAW] + (size_t)l * 1024 * 3072 + j0 + F.lane;
            for (int k = F.wave * 128; k < F.wave * 128 + 128; ++k) {
                const float w = wp[(size_t)k * 3072];
#pragma unroll
                for (int b = 0; b < 16; ++b) a[b] += sc[b * 1024 + k] * w;
            }
#pragma unroll
            for (int b = 0; b < 16; ++b) part[(F.wave * 16 + b) * 64 + F.lane] = a[b];
            __syncthreads();
            for (int i = F.tid; i < 16 * 64; i += 512) { const int b = i >> 6, j = i & 63; float s = 0.f;
#pragma unroll
                for (int w = 0; w < 8; ++w) s += part[(w * 16 + b) * 64 + j];
                mod_all[((size_t)l * 16 + b) * 3072 + j0 + j] = s + args.in[I_ADAB][l * 3072 + j0 + j]; }
            __syncthreads();
        }
        GRID_BAR();
    }
    if (KON(1) && IN(1)) {
        PHASE_BEGIN();
        for (int m = gw; m < MT; m += NGW) {
            const float* xrow = m < MP ? args.in[I_XP] + (size_t)m * DM : args.in[I_XS] + (size_t)(m - MP) * DM;
            xn_row(xrow, args.in[I_PREG], mod_all + (size_t)batch_of_row(m) * 3072, XN + (size_t)m * DM, F.lane);
        }
        GRID_BAR();
    }
    for (int l = 0; l < DEPTH; ++l) {
        const int pb = 2 + 8 * l;
        const float* mod_l = mod_all + (size_t)l * 16 * 3072;
        const bf16* W1 = (const bf16*)(ws + WS_W1) + (size_t)l * N1 * 1024;
        if (KON(2) && IN(pb + 0)) {
        PHASE_BEGIN();
            {
                const bf16* wl = (const bf16*)(ws + WS_WLRB) + (size_t)l * 16 * 1024;
                const int fr = F.lane & 15, fq = F.lane >> 4;
                for (int tile = gw; tile < MT / 16; tile += NGW) {
                    const bf16* ap = XN + (size_t)(16 * tile + fr) * DM + 8 * fq; const bf16* bp = wl + (size_t)fr * 1024 + 8 * fq;
                    pg8::f32x4 acc = {0.f, 0.f, 0.f, 0.f};
#pragma unroll 8
                    for (int s = 0; s < 32; ++s) {
                        const pg8::bf16x8 af = *(const GAS pg8::bf16x8*)(ap + 32 * s), bf = *(const GAS pg8::bf16x8*)(bp + 32 * s);
                        acc = __builtin_amdgcn_mfma_f32_16x16x32_bf16(af, bf, acc, 0, 0, 0);
                    }
#pragma unroll
                    for (int e = 0; e < 4; ++e) zlr[(size_t)(16 * tile + 4 * fq + e) * 16 + fr] = acc[e];
                }
            }
            __syncthreads();
            pg8::Gemm g{XN, W1, 1024, 1024, 1024}; pg8::StaticOrder S; S.init(MT / 256, N1A / 256, F.G, (int)blockIdx.x);
            pg8::EpiZ E{Z, ZP, dout + O_PP + (size_t)l * NB * 15 * 512, dout + O_PS + (size_t)l * NB * 15 * 512};
            pg8::gemm_phase<pg8::EpiZ, pg8::StaticOrder, true>(F.lds, g, S, E);
            GRID_BAR();
        }
        if (KON(3) && IN(pb + 1)) {
        PHASE_BEGIN();
            {
                LAS float* at = (LAS float*)F.lds;
                LAS unsigned char* DT = F.lds + 79 * 128 * 4;
                const int fr = F.lane & 15, fq = F.lane >> 4;
                for (int it = F.vcu; it < (MT / 64) * 4; it += F.G) {
                    const int tile = it >> 2, g = it & 3, w = 2 << g;
                    const int m0 = tile * 64; const bool smp = m0 >= MP;
                    const int bb = smp ? ((m0 - MP) >> 6) : (m0 >> 11), t0 = smp ? 0 : (m0 & 2047), pos0 = smp ? SEQ : 0;
                    for (int i = F.tid; i < 79 * 16; i += 512) {
                        const int ri = i >> 4, p = i & 15, t = t0 - 15 + ri; f32x4 v0 = {0.f, 0.f, 0.f, 0.f}, v1 = v0;
                        if (t >= 0) { const v4u raw = *(const GAS v4u*)(Z + (size_t)(m0 - 15 + ri) * ZP + CA + g * 128 + 8 * p);
                            v0 = (f32x4){pg8::bflo(raw.x), pg8::bfhi(raw.x), pg8::bflo(raw.y), pg8::bfhi(raw.y)}; v1 = (f32x4){pg8::bflo(raw.z), pg8::bfhi(raw.z), pg8::bflo(raw.w), pg8::bfhi(raw.w)}; }
                        else if (smp) { const float* sp = args.in[I_SPOOL] + (((size_t)l * NB + bb) * 15 + (15 + t)) * 512 + g * 128 + 8 * p; v0 = *(const f32x4*)sp; v1 = *(const f32x4*)(sp + 4); }
                        *(LAS f32x4*)(at + ri * 128 + 8 * p) = v0; *(LAS f32x4*)(at + ri * 128 + 8 * p + 4) = v1;
                    }
                    __syncthreads();
                    {
                        const int tt = F.tid >> 3, c0 = 16 * (F.tid & 7);
                        const int pos = pos0 + t0 + tt; const float rc = 1.0f / (float)((pos + 1) < w ? (pos + 1) : w);
                        f32x4 s[4];
#pragma unroll
                        for (int q = 0; q < 4; ++q) s[q] = (f32x4){0.f, 0.f, 0.f, 0.f};
                        for (int k = 0; k < w; ++k) {
#pragma unroll
                            for (int q = 0; q < 4; ++q) s[q] += *(const LAS f32x4*)(at + (tt + 15 - k) * 128 + c0 + 4 * q);
                        }
                        unsigned pk[8];
#pragma unroll
                        for (int q = 0; q < 4; ++q) { const f32x4 a0 = *(const LAS f32x4*)(at + (tt + 15) * 128 + c0 + 4 * q); const f32x4 dd = s[q] * rc - a0; pk[2 * q] = pk2(dd.x, dd.y); pk[2 * q + 1] = pk2(dd.z, dd.w); }
                        *(LAS v4u*)(DT + tt * 272 + c0 * 2) = (v4u){pk[0], pk[1], pk[2], pk[3]}; *(LAS v4u*)(DT + tt * 272 + c0 * 2 + 16) = (v4u){pk[4], pk[5], pk[6], pk[7]};
                    }
                    __syncthreads();
                    {
                        const int ctw = F.wave;
                        const bf16* pwt = (const bf16*)(ws + WS_PWT) + ((size_t)(l * 4 + g) * 128 + 16 * ctw + fr) * 128 + 8 * fq;
                        pg8::bf16x8 pwf[4];
#pragma unroll
                        for (int s2 = 0; s2 < 4; ++s2) pwf[s2] = *(const GAS pg8::bf16x8*)(pwt + 32 * s2);
                        const f32x4 ps = *(const f32x4*)(args.in[I_POOLS] + l * 512 + g * 128 + 16 * ctw + 4 * fq);
#pragma unroll
                        for (int rt = 0; rt < 4; ++rt) {
                            pg8::f32x4 acc = {0.f, 0.f, 0.f, 0.f};
#pragma unroll
                            for (int s2 = 0; s2 < 4; ++s2) { const pg8::bf16x8 df = *(const LAS pg8::bf16x8*)(DT + (16 * rt + fr) * 272 + (32 * s2 + 8 * fq) * 2); acc = __builtin_amdgcn_mfma_f32_16x16x32_bf16(pwf[s2], df, acc, 0, 0, 0); }
                            bf16* p = Z + (size_t)(m0 + 16 * rt + fr) * ZP + CGA + g * 128 + 16 * ctw + 4 * fq;
                            const v2u graw = *(const GAS v2u*)p;
                            v2u o; o.x = pk2(acc[0] * ps.x * siluf_(pg8::bflo(graw.x)), acc[1] * ps.y * siluf_(pg8::bfhi(graw.x))); o.y = pk2(acc[2] * ps.z * siluf_(pg8::bflo(graw.y)), acc[3] * ps.w * siluf_(pg8::bfhi(graw.y)));
                            *(GAS v2u*)p = o;
                        }
                    }
                    __syncthreads();
                }
            }
            {
                LAS unsigned char* VN = F.lds;
                LAS unsigned char* WT = F.lds + 128 * 272;
                const int fr = F.lane & 15, fq = F.lane >> 4;
                for (int it = F.vcu; it < 136 * 4; it += F.G) {
                    const int ch = it >> 2, g = it & 3;
                    const bool smp = ch >= 128; const int L = smp ? 64 : 128, m0 = smp ? MP + (ch - 128) * 64 : ch * 128;
                    for (int i = F.tid; i < 2048; i += 512) { const int row = i >> 4, p = i & 15;
                        *(LAS v4u*)(WT + row * 272 + p * 16) = *(const GAS v4u*)((const bf16*)(ws + WS_SGUW) + ((size_t)(l * 4 + g) * 128 + row) * 128 + 8 * p); }
                    for (int j = F.wave; j < L; j += 8) {
                        const v4u raw = *(const GAS v4u*)(Z + (size_t)(m0 + j) * ZP + CVB + 8 * F.lane);
                        float x[8]; x[0] = pg8::bflo(raw.x); x[1] = pg8::bfhi(raw.x); x[2] = pg8::bflo(raw.y); x[3] = pg8::bfhi(raw.y); x[4] = pg8::bflo(raw.z); x[5] = pg8::bfhi(raw.z); x[6] = pg8::bflo(raw.w); x[7] = pg8::bfhi(raw.w);
                        float s = 0.f;
#pragma unroll
                        for (int e = 0; e < 8; ++e) s += x[e];
                        const float mu = wave_sum(s) * (1.f / 512.f); float q = 0.f;
#pragma unroll
                        for (int e = 0; e < 8; ++e) { x[e] -= mu; q += x[e] * x[e]; }
                        const float rstd = 1.0f / sqrtf(wave_sum(q) * (1.f / 512.f) + EPS);
                        if ((F.lane >> 4) == g) {
                            const int c0 = 8 * (F.lane & 15);
                            const f32x4 g0 = *(const f32x4*)(args.in[I_SGUG] + l * 512 + g * 128 + c0), g1 = *(const f32x4*)(args.in[I_SGUG] + l * 512 + g * 128 + c0 + 4);
                            const f32x4 y0 = (f32x4){x[0], x[1], x[2], x[3]} * rstd * g0, y1 = (f32x4){x[4], x[5], x[6], x[7]} * rstd * g1;
                            *(LAS v4u*)(VN + j * 272 + c0 * 2) = (v4u){pk2(y0.x, y0.y), pk2(y0.z, y0.w), pk2(y1.x, y1.y), pk2(y1.z, y1.w)};
                            if (smp) { float* dp = dout + O_SV + (((size_t)l * NB + (ch - 128)) * 64 + j) * 512 + g * 128 + c0; *(f32x4*)dp = y0; *(f32x4*)(dp + 4) = y1; }
                        }
                    }
                    __syncthreads();
                    {
                        const int ctw = F.wave;
                        pg8::bf16x8 vfr[4];
#pragma unroll
                        for (int s2 = 0; s2 < 4; ++s2) {
                            if (32 * s2 < L) {
                                typedef short v4i16_t __attribute__((ext_vector_type(4)));
                                const int q_ = fr >> 2, p_ = F.lane & 3;
                                const v4i16_t lo = __builtin_amdgcn_ds_read_tr16_b64_v4i16((LAS v4i16_t*)(VN + (32 * s2 + 8 * fq + q_) * 272 + (16 * ctw + 4 * p_) * 2));
                                const v4i16_t hi = __builtin_amdgcn_ds_read_tr16_b64_v4i16((LAS v4i16_t*)(VN + (32 * s2 + 8 * fq + 4 + q_) * 272 + (16 * ctw + 4 * p_) * 2));
                                vfr[s2] = (pg8::bf16x8){lo[0], lo[1], lo[2], lo[3], hi[0], hi[1], hi[2], hi[3]};
                            } else vfr[s2] = (pg8::bf16x8){0, 0, 0, 0, 0, 0, 0, 0};
                        }
#pragma unroll
                        for (int rt = 0; rt < 8; ++rt) {
                            if (16 * rt < L) {
                                pg8::f32x4 acc = {0.f, 0.f, 0.f, 0.f};
#pragma unroll
                                for (int s2 = 0; s2 < 4; ++s2) if (s2 <= (rt >> 1)) { const pg8::bf16x8 wf = *(const LAS pg8::bf16x8*)(WT + (16 * rt + fr) * 272 + (32 * s2 + 8 * fq) * 2); acc = __builtin_amdgcn_mfma_f32_16x16x32_bf16(vfr[s2], wf, acc, 0, 0, 0); }
                                const int i = 16 * rt + fr; const float bias = args.in[I_SGUB][(l * 4 + g) * 128 + i];
                                const size_t rb = (size_t)(m0 + i) * ZP + g * 128 + 16 * ctw + 4 * fq;
                                const v2u uraw = *(const GAS v2u*)(Z + rb + CU), graw = *(const GAS v2u*)(Z + rb + CGB);
                                v2u o; o.x = pk2(pg8::bflo(uraw.x) * (acc[0] + bias) * siluf_(pg8::bflo(graw.x)), pg8::bfhi(uraw.x) * (acc[1] + bias) * siluf_(pg8::bfhi(graw.x)));
                                o.y = pk2(pg8::bflo(uraw.y) * (acc[2] + bias) * siluf_(pg8::bflo(graw.y)), pg8::bfhi(uraw.y) * (acc[3] + bias) * siluf_(pg8::bfhi(graw.y)));
                                *(GAS v2u*)(Z + rb + CGB) = o;
                            }
                        }
                    }
                    __syncthreads();
                }
            }
            {
                constexpr int PQ = 272;
                LAS unsigned char* QT = F.lds;
                LAS unsigned char* KT = F.lds + 64 * PQ;
                LAS float* tot = (LAS float*)(F.lds + 2 * 64 * PQ);
                const int d = F.tid & 127, tg = __builtin_amdgcn_readfirstlane(F.tid >> 7);
                for (int it = F.vcu; it < 1056; it += F.G) {
                    const bool smp = it >= 1024; const int bh = smp ? it - 1024 : it >> 5, c = smp ? 0 : it & 31, bb = bh >> 2, h = bh & 3;
                    const int mb = (smp ? MP + bb * 64 : bb * SEQ) + c * 64;
                    float w2[16];
#pragma unroll
                    for (int r = 0; r < 16; ++r) w2[r] = args.in[I_WA2][(size_t)l * 16 * 512 + r * 512 + h * 128 + d];
                    const float bad = args.in[I_BA][l * 512 + h * 128 + d];
                    float bl[16], qv[16], kv[16]; float run = 0.f;
#pragma unroll
                    for (int i = 0; i < 16; ++i) {
                        const size_t m = (size_t)(mb + 16 * tg + i);
                        const float* zr = zlr + m * 16; float x = bad;
#pragma unroll
                        for (int r = 0; r < 16; ++r) x += zr[r] * w2[r];
                        const float ls = fminf(x, 0.f) - log1pf(__expf(-fabsf(x)));
                        run += ls * (1.0f / 16.0f); bl[i] = run;
                        qv[i] = bf2f(Z[m * ZP + CQ + h * 128 + d]); kv[i] = bf2f(Z[m * ZP + CK + h * 128 + d]);
                    }
                    tot[tg * 128 + d] = run;
                    asm volatile("s_waitcnt vmcnt(0)" ::: "memory");
                    __syncthreads();
                    float off = 0.f, total = 0.f;
#pragma unroll
                    for (int g2 = 0; g2 < 4; ++g2) { const float tv = tot[g2 * 128 + d]; total += tv; if (g2 < tg) off += tv; }
                    unsigned kp[8];
#pragma unroll
                    for (int i = 0; i < 16; ++i) {
                        const float b = off + bl[i]; const float eb = __expf(b);
                        const unsigned qb = f2bf(qv[i] * 0.08838834764831845f * eb), kb = f2bf(kv[i] * __expf(-b));
                        const int t = 16 * tg + i;
                        *(LAS bf16*)(QT + t * PQ + d * 2) = (bf16)qb; *(LAS bf16*)(KT + t * PQ + d * 2) = (bf16)kb;
                        Z[(size_t)(mb + t) * ZP + CQ + h * 128 + d] = (bf16)qb;
                        if (i & 1) kp[i >> 1] |= kb << 16; else kp[i >> 1] = kb;
                    }
                    {
                        bf16* kd = Z + (size_t)(mb + (d >> 1)) * ZP + CK + h * 128 + (d & 1) * 64 + 16 * tg;
                        *(v4u*)kd = (v4u){kp[0], kp[1], kp[2], kp[3]}; *(v4u*)(kd + 8) = (v4u){kp[4], kp[5], kp[6], kp[7]};
                    }
                    float* decg = (float*)(ws + WS_DEC) + (size_t)it * 128;
                    if (tg == 0) decg[d] = __expf(total);
                    __syncthreads();
                    {
                        const int lane = F.lane, rt = F.wave & 3, fr = lane & 15, fq = lane >> 4;
                        bf16* ab = (bf16*)(ws + WS_ABUF) + (size_t)it * 2560;
#pragma unroll
                        for (int cc = 0; cc < 2; ++cc) {
                            const int ct = 2 * (F.wave >> 2) + cc;
                            if (ct <= rt) {
                                pg8::f32x4 acc = {0.f, 0.f, 0.f, 0.f};
#pragma unroll
                                for (int s = 0; s < 4; ++s) {
                                    const pg8::bf16x8 kf = *(const LAS pg8::bf16x8*)(KT + (16 * ct + fr) * PQ + (32 * s + 8 * fq) * 2);
                                    const pg8::bf16x8 qf = *(const LAS pg8::bf16x8*)(QT + (16 * rt + fr) * PQ + (32 * s + 8 * fq) * 2);
                                    acc = __builtin_amdgcn_mfma_f32_16x16x32_bf16(kf, qf, acc, 0, 0, 0);
                                }
                                const int t = 16 * rt + fr, j0 = 16 * ct + 4 * fq;
                                v2u w;
                                w.x = pk2(j0 + 0 <= t ? acc[0] : 0.f, j0 + 1 <= t ? acc[1] : 0.f); w.y = pk2(j0 + 2 <= t ? acc[2] : 0.f, j0 + 3 <= t ? acc[3] : 0.f);
                                *(v2u*)(ab + (rt * (rt + 1) / 2 + ct) * 256 + fr * 16 + 4 * fq) = w;
                            }
                        }
                    }
                    __syncthreads();
                }
            }
            GRID_BAR();
        }
        if (KON(9) && IN(pb + 2)) {
        PHASE_BEGIN();
            constexpr int SB_A = 0, SB_Q = 9216, SB_KT = 26624, SB_V = 45056, SB_DEC = 50176, SB_SZ = 50688, SB_ST = 2 * SB_SZ, ST_SZ = 8704;
            constexpr int PA = 144, PQ2 = 272, PK = 144, PV = 80, PS = 272;
            const int tid = F.tid, lane = F.lane, fr = lane & 15, fq = lane >> 4;
            const int ct = F.wave & 1, rto = F.wave >> 1;
            for (int u = tid; u < 2 * SB_SZ / 16; u += 512) *(LAS v4u*)(F.lds + u * 16) = (v4u){0u, 0u, 0u, 0u};
            __syncthreads();
            for (int it = F.vcu; it < 512; it += F.G) {
                const bool smp = it >= 256; const int id = it & 255, bh = id >> 3, sl = id & 7, bb = bh >> 2, h = bh & 3;
                const int nch = smp ? 1 : 32, m0 = smp ? MP + bb * 64 : bb * SEQ, item0 = smp ? 1024 + bh : bh * 32;
                const int dvc = h * 256 + 32 * sl;
                pg8::f32x4 accS[2];
                float* sout = dout + (smp ? O_GS : O_GP) + (((size_t)l * NB + bb) * 4 + h) * 128 * 256 + 32 * sl + 16 * ct + fr;
                if (smp) {
                    const float* s0 = args.in[I_SGLA] + (((size_t)l * NB + bb) * 4 + h) * 128 * 256 + 32 * sl + 16 * ct + fr;
#pragma unroll
                    for (int k2 = 0; k2 < 2; ++k2)
#pragma unroll
                        for (int i = 0; i < 4; ++i) accS[k2][i] = s0[(size_t)(16 * (2 * rto + k2) + 4 * fq + i) * 256];
                } else { accS[0] = (pg8::f32x4){0.f, 0.f, 0.f, 0.f}; accS[1] = accS[0]; }
                v4u rA, rQ0, rQ1, rK0, rK1, rV; float rD;
                const int a_tau = tid >> 5, a_rt = (a_tau >= 6) ? 3 : (a_tau >= 3) ? 2 : (a_tau >= 1) ? 1 : 0, a_ct = a_tau - a_rt * (a_rt + 1) / 2, a_p = tid & 31;
#define SC_LOAD(cidx) do { const int mb_ = m0 + 64 * (cidx); const size_t itm_ = (size_t)(item0 + (cidx)); \
                    if (tid < 320) rA = *(const GAS v4u*)((const bf16*)(ws + WS_ABUF) + itm_ * 2560 + tid * 8); \
                    rQ0 = *(const GAS v4u*)(Z + (size_t)(mb_ + (tid >> 4)) * ZP + CQ + h * 128 + 8 * (tid & 15)); \
                    rQ1 = *(const GAS v4u*)(Z + (size_t)(mb_ + 32 + (tid >> 4)) * ZP + CQ + h * 128 + 8 * (tid & 15)); \
                    rK0 = *(const GAS v4u*)(Z + (size_t)(mb_ + (tid >> 4)) * ZP + CK + h * 128 + 8 * (tid & 15)); \
                    rK1 = *(const GAS v4u*)(Z + (size_t)(mb_ + 32 + (tid >> 4)) * ZP + CK + h * 128 + 8 * (tid & 15)); \
                    if (tid < 256) rV = *(const GAS v4u*)(Z + (size_t)(mb_ + (tid >> 2)) * ZP + CVC + dvc + 8 * (tid & 3)); \
                    if (tid < 128) rD = ((const float*)(ws + WS_DEC))[itm_ * 128 + tid]; } while (0)
#define SC_STORE(bufi) do { LAS unsigned char* B_ = F.lds + (bufi) * SB_SZ; \
                    if (tid < 320) *(LAS v4u*)(B_ + SB_A + (16 * a_rt + (a_p >> 1)) * PA + (16 * a_ct + 8 * (a_p & 1)) * 2) = rA; \
                    *(LAS v4u*)(B_ + SB_Q + (tid >> 4) * PQ2 + (tid & 15) * 16) = rQ0; *(LAS v4u*)(B_ + SB_Q + (32 + (tid >> 4)) * PQ2 + (tid & 15) * 16) = rQ1; \
                    { const int r0_ = tid >> 4, p_ = tid & 15; \
                      *(LAS v4u*)(B_ + SB_KT + (2 * r0_ + (p_ >> 3)) * PK + (p_ & 7) * 16) = rK0; *(LAS v4u*)(B_ + SB_KT + (2 * (32 + r0_) + (p_ >> 3)) * PK + (p_ & 7) * 16) = rK1; } \
                    if (tid < 256) *(LAS v4u*)(B_ + SB_V + (tid >> 2) * PV + (tid & 3) * 16) = rV; \
                    if (tid < 128) *(LAS float*)(B_ + SB_DEC + tid * 4) = rD; } while (0)
#define SC_PUBLISH(sti) do { LAS unsigned char* S_ = F.lds + SB_ST + (sti) * ST_SZ; \
                    _Pragma("unroll") for (int k2 = 0; k2 < 2; ++k2) { v2u w_; w_.x = pk2(accS[k2][0], accS[k2][1]); w_.y = pk2(accS[k2][2], accS[k2][3]); \
                        *(LAS v2u*)(S_ + (16 * ct + fr) * PS + (16 * (2 * rto + k2) + 4 * fq) * 2) = w_; } } while (0)
                SC_LOAD(0);
                SC_STORE(0);
                SC_PUBLISH(0);
                __syncthreads();
                for (int c = 0; c < nch; ++c) {
                    const int cb = c & 1;
                    if (c + 1 < nch) SC_LOAD(c + 1);
                    asm volatile("" ::: "memory");
                    LAS unsigned char* B = F.lds + cb * SB_SZ; LAS unsigned char* ST = F.lds + SB_ST + cb * ST_SZ;
                    pg8::bf16x8 vf[2];
#pragma unroll
                    for (int s = 0; s < 2; ++s) {
                        typedef short v4i16_t __attribute__((ext_vector_type(4)));
                        const int q_ = fr >> 2, p_ = lane & 3;
                        const v4i16_t lo = __builtin_amdgcn_ds_read_tr16_b64_v4i16((LAS v4i16_t*)(B + SB_V + (32 * s + 8 * fq + q_) * PV + (16 * ct + 4 * p_) * 2));
                        const v4i16_t hi = __builtin_amdgcn_ds_read_tr16_b64_v4i16((LAS v4i16_t*)(B + SB_V + (32 * s + 8 * fq + 4 + q_) * PV + (16 * ct + 4 * p_) * 2));
                        vf[s] = (pg8::bf16x8){lo[0], lo[1], lo[2], lo[3], hi[0], hi[1], hi[2], hi[3]};
                    }
                    pg8::f32x4 ao = {0.f, 0.f, 0.f, 0.f};
#pragma unroll
                    for (int s = 0; s < 2; ++s) {
                        const pg8::bf16x8 af = *(const LAS pg8::bf16x8*)(B + SB_A + (16 * rto + fr) * PA + (32 * s + 8 * fq) * 2);
                        ao = __builtin_amdgcn_mfma_f32_16x16x32_bf16(vf[s], af, ao, 0, 0, 0);
                    }
#pragma unroll
                    for (int s = 0; s < 4; ++s) {
                        const pg8::bf16x8 sf = *(const LAS pg8::bf16x8*)(ST + (16 * ct + fr) * PS + (32 * s + 8 * fq) * 2);
                        const pg8::bf16x8 qf = *(const LAS pg8::bf16x8*)(B + SB_Q + (16 * rto + fr) * PQ2 + (32 * s + 8 * fq) * 2);
                        ao = __builtin_amdgcn_mfma_f32_16x16x32_bf16(sf, qf, ao, 0, 0, 0);
                    }
                    {
                        v2u w; w.x = pk2(ao[0], ao[1]); w.y = pk2(ao[2], ao[3]);
                        *(GAS v2u*)(Z + (size_t)(m0 + 64 * c + 16 * rto + fr) * ZP + CVC + dvc + 16 * ct + 4 * fq) = w;
                    }
#pragma unroll
                    for (int k2 = 0; k2 < 2; ++k2) {
                        const int rt = 2 * rto + k2;
#pragma unroll
                        for (int s = 0; s < 2; ++s) {
                            const pg8::bf16x8 kf = *(const LAS pg8::bf16x8*)(B + SB_KT + (16 * rt + fr) * PK + (32 * s + 8 * fq) * 2);
                            accS[k2] = __builtin_amdgcn_mfma_f32_16x16x32_bf16(kf, vf[s], accS[k2], 0, 0, 0);
                        }
                        const pg8::f32x4 dc = *(const LAS pg8::f32x4*)(B + SB_DEC + (16 * rt + 4 * fq) * 4);
                        accS[k2] = accS[k2] * dc;
                    }
                    SC_PUBLISH(cb ^ 1);
                    asm volatile("" ::: "memory");
                    if (c + 1 < nch) SC_STORE(cb ^ 1);
                    __syncthreads();
                }
#pragma unroll
                for (int k2 = 0; k2 < 2; ++k2)
#pragma unroll
                    for (int i = 0; i < 4; ++i) sout[(size_t)(16 * (2 * rto + k2) + 4 * fq + i) * 256] = accS[k2][i];
#undef SC_LOAD
#undef SC_STORE
#undef SC_PUBLISH
            }
            GRID_BAR();
        }
        if (KON(4) && IN(pb + 3)) {
        PHASE_BEGIN();
            for (int m = gw; m < MT; m += NGW) {
                v2u raw[4], graw[4]; float ss[4];
#pragma unroll
                for (int h = 0; h < 4; ++h) { raw[h] = *(const GAS v2u*)(Z + (size_t)m * ZP + CVC + h * 256 + 4 * F.lane); graw[h] = *(const GAS v2u*)(Z + (size_t)m * ZP + CGC + h * 256 + 4 * F.lane); }
                const f32x4 gg = *(const f32x4*)(args.in[I_GLAG] + l * 256 + 4 * F.lane);
#pragma unroll
                for (int h = 0; h < 4; ++h) { const float o0 = pg8::bflo(raw[h].x), o1 = pg8::bfhi(raw[h].x), o2 = pg8::bflo(raw[h].y), o3 = pg8::bfhi(raw[h].y); ss[h] = wave_sum((o0 * o0 + o1 * o1) + (o2 * o2 + o3 * o3)); }
#pragma unroll
                for (int h = 0; h < 4; ++h) {
                    const float rstd = 1.0f / sqrtf(ss[h] * (1.f / 256.f) + EPS);
                    v2u w; w.x = pk2(pg8::bflo(raw[h].x) * rstd * gg.x * siluf_(pg8::bflo(graw[h].x)), pg8::bfhi(raw[h].x) * rstd * gg.y * siluf_(pg8::bfhi(graw[h].x)));
                    w.y = pk2(pg8::bflo(raw[h].y) * rstd * gg.z * siluf_(pg8::bflo(graw[h].y)), pg8::bfhi(raw[h].y) * rstd * gg.w * siluf_(pg8::bfhi(graw[h].y)));
                    *(GAS v2u*)(Z + (size_t)m * ZP + CVC + h * 256 + 4 * F.lane) = w;
                }
            }
            GRID_BAR();
        }
        if (KON(5) && IN(pb + 4)) {
        PHASE_BEGIN();
            pg8::Gemm g{XN, W1 + (size_t)N1A * 1024, 1024, 1024, 1024}; pg8::StaticOrder S; S.init(MT / 256, N1B / 256, F.G, (int)blockIdx.x);
            pg8::EpiGm E{Z, ZP};
            pg8::gemm_phase<pg8::EpiGm, pg8::StaticOrder, true>(F.lds, g, S, E);
            GRID_BAR();
        }
        if (KON(6) && IN(pb + 5)) {
        PHASE_BEGIN();
            pg8::Gemm g{Z + CY, (const bf16*)(ws + WS_WCAT) + (size_t)l * 1024 * 2048, ZP, 2048, 2048}; pg8::StaticOrder S; S.init(MT / 256, 4, F.G, (int)blockIdx.x);
            pg8::EpiMerge E{Z, ZP, XN, 1024};
            pg8::gemm_phase<pg8::EpiMerge, pg8::StaticOrder, true>(F.lds, g, S, E);
            GRID_BAR();
        }
        if (KON(7) && IN(pb + 6)) {
        PHASE_BEGIN();
            pg8::Gemm g{XN, (const bf16*)(ws + WS_WOUT) + (size_t)l * 1024 * 1024, 1024, 1024, 1024}; pg8::StaticOrder S; S.init(MT / 256, 4, F.G, (int)blockIdx.x);
            pg8::EpiF32 E{OUTF, 1024};
            pg8::gemm_phase<pg8::EpiF32, pg8::StaticOrder, true>(F.lds, g, S, E);
            GRID_BAR();
        }
        if (KON(8) && IN(pb + 7)) {
        PHASE_BEGIN();
            for (int m = gw; m < MT; m += NGW) {
                const float* xprev = (l == 0) ? (m < MP ? args.in[I_XP] + (size_t)m * DM : args.in[I_XS] + (size_t)(m - MP) * DM) : dout + (size_t)m * DM;
                const GAS f32x4* orow = (const GAS f32x4*)(OUTF + (size_t)m * DM) + F.lane;
                const float* modb = mod_l + (size_t)batch_of_row(m) * 3072;
                f32x4 v[4]; float s = 0.f;
#pragma unroll
                for (int j = 0; j < 4; ++j) { v[j] = orow[64 * j]; s += (v[j].x * v[j].x + v[j].y * v[j].y) + (v[j].z * v[j].z + v[j].w * v[j].w); }
                const float rstd = 1.0f / sqrtf(wave_sum(s) * (1.f / DM) + EPS);
                float s2 = 0.f;
#pragma unroll
                for (int j = 0; j < 4; ++j) {
                    const int c = 4 * F.lane + 256 * j;
                    const f32x4 pg = *(const f32x4*)(args.in[I_POSTG] + l * 1024 + c), gt = *(const f32x4*)(modb + 2048 + c), xp = *(const f32x4*)(xprev + c);
                    v[j] = xp + gt * ((v[j] * rstd) * pg);
                    *(f32x4*)(dout + (size_t)m * DM + c) = v[j];
                    s2 += (v[j].x * v[j].x + v[j].y * v[j].y) + (v[j].z * v[j].z + v[j].w * v[j].w);
                }
                if (l + 1 < DEPTH) {
                    const float rstd2 = 1.0f / sqrtf(wave_sum(s2) * (1.f / DM) + EPS);
                    const float* modn = mod_all + ((size_t)(l + 1) * 16 + batch_of_row(m)) * 3072;
                    GAS unsigned long long* o8 = (GAS unsigned long long*)(XN + (size_t)m * DM) + F.lane;
#pragma unroll
                    for (int j = 0; j < 4; ++j) {
                        const int c = 4 * F.lane + 256 * j;
                        const f32x4 gg = *(const f32x4*)(args.in[I_PREG] + (l + 1) * 1024 + c), sh = *(const f32x4*)(modn + c), sc = *(const f32x4*)(modn + 1024 + c);
                        const f32x4 hh = (v[j] * rstd2) * gg * (sc + 1.0f) + sh;
                        o8[64 * j] = (unsigned long long)pk2(hh.x, hh.y) | ((unsigned long long)pk2(hh.z, hh.w) << 32);
                    }
                }
            }
            if (l + 1 < DEPTH) GRID_BAR();
        }
    }
#undef IN
#undef GRID_BAR
}

extern "C" void kernel_launch(void* const* d_in, const int* in_sizes, int n_in, void* d_out, int out_size, void* d_ws, size_t ws_size, hipStream_t stream) {
    static int grid = 0;
    if (grid == 0) {
        if (n_in != N_IN || out_size != (int)O_END || ws_size < WS_END) { fprintf(stderr, "kernel_launch: unexpected shapes: n_in %d out %d ws %zu (need %zu)\n", n_in, out_size, ws_size, (size_t)WS_END); grid = -1; return; }
        int dev = 0, cus = 0;
        if (hipGetDevice(&dev) != hipSuccess || hipDeviceGetAttribute(&cus, hipDeviceAttributeMultiprocessorCount, dev) != hipSuccess) { grid = -1; return; }
        if (hipFuncSetAttribute((const void*)mk_fwd, hipFuncAttributeMaxDynamicSharedMemorySize, LDS_BYTES) != hipSuccess) { grid = -1; return; }
        grid = cus;
    }
    if (grid < 0) return;
    (void)hipMemsetAsync((char*)d_ws + WS_CTL, 0, CTL_ZERO_BYTES, stream);
    Args a{};
    for (int i = 0; i < N_IN; ++i) a.in[i] = (const float*)d_in[i];
    a.out = (float*)d_out; a.ws = (unsigned char*)d_ws;
#if MK_N_LAUNCHES == 1
    a.ph_lo = 0; a.ph_hi = NPH; a.li = 0;
    hipLaunchKernelGGL(mk_fwd, dim3(grid), dim3(NWAVES * 64), LDS_BYTES, stream, a);
#else
    for (int p = 0; p < NPH; ++p) { a.ph_lo = p; a.ph_hi = p + 1; a.li = p; hipLaunchKernelGGL(mk_fwd, dim3(grid), dim3(NWAVES * 64), LDS_BYTES, stream, a); }
#endif
}
```

```cpp
#include <hip/hip_runtime.h>
#include <cstdio>
#include <cstdint>

#ifndef MK_N_LAUNCHES
#define MK_N_LAUNCHES 1
#endif

namespace pg8 {
#define PG8_LAS __attribute__((address_space(3)))
typedef unsigned short bf16_t;
typedef short bf16x8 __attribute__((ext_vector_type(8)));
typedef float f32x4 __attribute__((ext_vector_type(4)));
typedef unsigned u32x4 __attribute__((ext_vector_type(4)));
constexpr int BM = 256, BK = 64, HALF = 128, HTB = HALF * BK * 2, STAGE_BYTES = 8 * HTB, NXCD = 8, WGM = 8;

__host__ __device__ __forceinline__ int lds_byte(int r, int c) { const int st = (r >> 4) * 2 + (c >> 5), rr = r & 15, cc = c & 31, ob = rr * 64 + cc * 2; return st * 1024 + (ob ^ (((ob >> 9) & 1) << 5)); }
__host__ __device__ __forceinline__ void stage_rc(int b, int& R, int& C) { const int st = b / 1024, sb = b % 1024, swz = sb ^ (((sb >> 9) & 1) << 5); R = (st >> 1) * 16 + swz / 64; C = (st & 1) * 32 + (swz % 64) / 2; }
__host__ __device__ __forceinline__ int perm32(int rho) { const int n = rho >> 4, i = rho & 15; return 8 * (i >> 2) + 4 * n + (i & 3); }

struct Unit { int pm, pn; };
struct Gemm { const bf16_t* A; const bf16_t* Bt; int lda, ldb, K; };

struct StaticOrder {
    int nM, nN, nwg, G, c;
    __host__ __device__ void init(int nM_, int nN_, int G_, int c_) { nM = nM_; nN = nN_; nwg = nM * nN; G = G_; c = c_; }
    __host__ __device__ bool next(int i, Unit& u) const {
        const long L = (long)i * G + c; if (L >= nwg) return false;
        int wgid = (int)L; { const int q = nwg / NXCD, r = nwg % NXCD, xcd = wgid % NXCD, off = wgid / NXCD; wgid = (xcd < r ? xcd * (q + 1) : r * (q + 1) + (xcd - r) * q) + off; }
        const int nig = WGM * nN, gid = wgid / nig, fm = gid * WGM, gsz = (nM - fm) < WGM ? (nM - fm) : WGM;
        u.pm = fm + ((wgid % nig) % gsz); u.pn = (wgid % nig) / gsz; return true;
    }
};

typedef float f32x2_t __attribute__((ext_vector_type(2))); typedef __bf16 bf16x2_t __attribute__((ext_vector_type(2)));
__device__ __forceinline__ unsigned cvt_pk_bf16(float lo, float hi) { f32x2_t v = {lo, hi}; bf16x2_t b = __builtin_convertvector(v, bf16x2_t); return __builtin_bit_cast(unsigned, b); }
__device__ __forceinline__ float bflo(unsigned w) { return __uint_as_float(w << 16); }
__device__ __forceinline__ float bfhi(unsigned w) { return __uint_as_float(w & 0xffff0000u); }
__device__ __forceinline__ float sigmoidf_(float x) { return __builtin_amdgcn_rcpf(1.0f + __builtin_amdgcn_exp2f(-1.4426950408889634f * x)); }

struct EpiZ {
    static constexpr bool PERM = true, AFTER_DRAIN = false, KHOOK = false;
    bf16_t* Z; int ldz; float* pool_p; float* pool_s;
    __device__ __forceinline__ void operator()(const f32x4 (&acc)[2][2][4][2], const Unit& u, int wr, int wc, int fr, int fq) const {
        const int row0 = u.pm * BM + wr * 64 + fr, col0 = u.pn * BM + wc * 32 + 8 * fq;
#pragma unroll
        for (int ai = 0; ai < 2; ++ai)
#pragma unroll
            for (int m = 0; m < 4; ++m) {
                const int r = row0 + ai * HALF + m * 16; bf16_t* rowp = Z + (size_t)r * ldz + col0;
                float* prow = nullptr;
                if (u.pn < 2) {
                    if (r < 16384) { const int t = r & 2047; if (t >= 2033) prow = pool_p + (size_t)((r >> 11) * 15 + (t - 2033)) * 512; }
                    else { const int rs = r - 16384, t = rs & 63; if (t >= 49) prow = pool_s + (size_t)((rs >> 6) * 15 + (t - 49)) * 512; }
                }
#pragma unroll
                for (int bj = 0; bj < 2; ++bj) {
                    const f32x4 v0 = acc[ai][bj][m][0], v1 = acc[ai][bj][m][1];
                    u32x4 w; w.x = cvt_pk_bf16(v0[0], v0[1]); w.y = cvt_pk_bf16(v0[2], v0[3]); w.z = cvt_pk_bf16(v1[0], v1[1]); w.w = cvt_pk_bf16(v1[2], v1[3]);
                    *(u32x4*)(rowp + bj * HALF) = w;
                    if (prow) { *(f32x4*)(prow + col0 + bj * HALF) = v0; *(f32x4*)(prow + col0 + bj * HALF + 4) = v1; }
                }
            }
    }
};
struct EpiGm {
    static constexpr bool PERM = true, AFTER_DRAIN = false, KHOOK = false;
    bf16_t* Z; int ldz;
    __device__ __forceinline__ void operator()(const f32x4 (&acc)[2][2][4][2], const Unit& u, int wr, int wc, int fr, int fq) const {
        const int row0 = u.pm * BM + wr * 64 + fr, col0 = u.pn * BM + wc * 32 + 8 * fq;
#pragma unroll
        for (int ai = 0; ai < 2; ++ai)
#pragma unroll
            for (int m = 0; m < 4; ++m) {
                bf16_t* rowp = Z + (size_t)(row0 + ai * HALF + m * 16) * ldz + col0;
#pragma unroll
                for (int bj = 0; bj < 2; ++bj) {
                    const f32x4 v0 = acc[ai][bj][m][0], v1 = acc[ai][bj][m][1];
                    u32x4 w; w.x = cvt_pk_bf16(sigmoidf_(v0[0]), sigmoidf_(v0[1])); w.y = cvt_pk_bf16(sigmoidf_(v0[2]), sigmoidf_(v0[3]));
                    w.z = cvt_pk_bf16(sigmoidf_(v1[0]), sigmoidf_(v1[1])); w.w = cvt_pk_bf16(sigmoidf_(v1[2]), sigmoidf_(v1[3]));
                    *(u32x4*)(rowp + bj * HALF) = w;
                }
            }
    }
};
struct EpiMerge {
    static constexpr bool PERM = true, AFTER_DRAIN = false, KHOOK = true;
    const bf16_t* G; int ldg; bf16_t* Mo; int ldm;
    __device__ __forceinline__ void khook(f32x4 (&acc)[2][2][4][2], const Unit& u, int t, int wr, int wc, int fr, int fq) const {
        if (t != 8 && t != 16) return;
        const int br = (t == 8) ? 0 : 1;
        asm volatile("" : "+v"(fr), "+v"(fq));
        const int row0 = u.pm * BM + wr * 64 + fr, col0 = u.pn * BM + wc * 32 + 8 * fq;
#pragma unroll
        for (int ai = 0; ai < 2; ++ai)
#pragma unroll
            for (int m = 0; m < 4; ++m) {
                const bf16_t* gp = G + (size_t)(row0 + ai * HALF + m * 16) * ldg + br * 1024 + col0;
#pragma unroll
                for (int bj = 0; bj < 2; ++bj) {
                    const u32x4 nu = *(const u32x4*)(gp + bj * HALF), de = *(const u32x4*)(gp + 1024 + bj * HALF);
                    f32x4 r0, r1;
                    r0[0] = bflo(nu.x) * __builtin_amdgcn_rcpf(bflo(de.x)); r0[1] = bfhi(nu.x) * __builtin_amdgcn_rcpf(bfhi(de.x));
                    r0[2] = bflo(nu.y) * __builtin_amdgcn_rcpf(bflo(de.y)); r0[3] = bfhi(nu.y) * __builtin_amdgcn_rcpf(bfhi(de.y));
                    r1[0] = bflo(nu.z) * __builtin_amdgcn_rcpf(bflo(de.z)); r1[1] = bfhi(nu.z) * __builtin_amdgcn_rcpf(bfhi(de.z));
                    r1[2] = bflo(nu.w) * __builtin_amdgcn_rcpf(bflo(de.w)); r1[3] = bfhi(nu.w) * __builtin_amdgcn_rcpf(bfhi(de.w));
                    acc[ai][bj][m][0] *= r0; acc[ai][bj][m][1] *= r1;
                }
                asm volatile("" ::: "memory");
            }
    }
    __device__ __forceinline__ void operator()(const f32x4 (&acc)[2][2][4][2], const Unit& u, int wr, int wc, int fr, int fq) const {
        const int row0 = u.pm * BM + wr * 64 + fr, col0 = u.pn * BM + wc * 32 + 8 * fq;
#pragma unroll
        for (int ai = 0; ai < 2; ++ai)
#pragma unroll
            for (int m = 0; m < 4; ++m) {
                const int r = row0 + ai * HALF + m * 16;
                const bf16_t* gp = G + (size_t)r * ldg + 2048 + col0; bf16_t* rowp = Mo + (size_t)r * ldm + col0;
#pragma unroll
                for (int bj = 0; bj < 2; ++bj) {
                    const u32x4 g = *(const u32x4*)(gp + bj * HALF);
                    const f32x4 v0 = acc[ai][bj][m][0], v1 = acc[ai][bj][m][1];
                    u32x4 w; w.x = cvt_pk_bf16(v0[0] * bflo(g.x), v0[1] * bfhi(g.x)); w.y = cvt_pk_bf16(v0[2] * bflo(g.y), v0[3] * bfhi(g.y));
                    w.z = cvt_pk_bf16(v1[0] * bflo(g.z), v1[1] * bfhi(g.z)); w.w = cvt_pk_bf16(v1[2] * bflo(g.w), v1[3] * bfhi(g.w));
                    *(u32x4*)(rowp + bj * HALF) = w;
                }
            }
    }
};
struct EpiF32 {
    static constexpr bool PERM = false, AFTER_DRAIN = false, KHOOK = false;
    float* C; int ldc;
    __device__ __forceinline__ void operator()(const f32x4 (&acc)[2][2][4][2], const Unit& u, int wr, int wc, int fr, int fq) const {
        const int row0 = u.pm * BM + wr * 64 + fr, col0 = u.pn * BM + wc * 32 + 4 * fq;
#pragma unroll
        for (int ai = 0; ai < 2; ++ai)
#pragma unroll
            for (int m = 0; m < 4; ++m) { float* rowp = C + (size_t)(row0 + ai * HALF + m * 16) * ldc + col0;
#pragma unroll
                for (int bj = 0; bj < 2; ++bj)
#pragma unroll
                    for (int n = 0; n < 2; ++n) *(f32x4*)(rowp + bj * HALF + n * 16) = acc[ai][bj][m][n]; }
    }
};

template <class Epi, class Sched, bool ALIGN_EPI>
__device__ __forceinline__ void gemm_phase(PG8_LAS unsigned char* lds, const Gemm g, const Sched& S, const Epi& E) {
    int tid_ = threadIdx.x; asm volatile("" : "+v"(tid_));
    const int tid = tid_, wid = __builtin_amdgcn_readfirstlane(tid >> 6), lane = tid & 63, wr = wid >> 2, wc = wid & 3, fr = lane & 15, fq = lane >> 4;
    const int K = g.K, nt = K / BK;
    unsigned voffA[2], voffB[2];
#pragma unroll
    for (int i = 0; i < 2; ++i) { int R, C; stage_rc(tid * 16 + i * 8192, R, C); const int Rb = Epi::PERM ? ((R & ~31) + perm32(R & 31)) : R;
        voffA[i] = (unsigned)(R * g.lda + C) * 2u; voffB[i] = (unsigned)(Rb * g.ldb + C) * 2u; }
    const size_t kstep = (size_t)(BK * 2);
    const size_t hstepA = (size_t)HALF * g.lda * 2, hstepB = (size_t)HALF * g.ldb * 2;
    const size_t tstepA = 2 * hstepA, tstepB = 2 * hstepB;
    const unsigned ldsw = (unsigned)wid * 1024u;
    const int aoff = lds_byte(wr * 64 + fr, fq * 8), boff = lds_byte(wc * 32 + fr, fq * 8);
#define PG8_SA(b, h) (((b) * 2 + (h)) * HTB)
#define PG8_SB(b, h) ((4 + (b) * 2 + (h)) * HTB)
#define PG8_STAGE(bufoff, gbase, voff) do { _Pragma("unroll") for (int _i = 0; _i < 2; ++_i) \
        __builtin_amdgcn_global_load_lds((const unsigned*)((const char*)(gbase) + (voff)[_i]), (PG8_LAS unsigned*)(lds + (bufoff) + ldsw + _i * 8192), 16, 0, 0); } while (0)
#define PG8_LDA(dst, b, h) do { _Pragma("unroll") for (int m = 0; m < 4; ++m) _Pragma("unroll") for (int k = 0; k < 2; ++k) dst[m][k] = *(const PG8_LAS bf16x8*)(lds + PG8_SA(b, h) + aoff + m * 2048 + k * 1024); } while (0)
#define PG8_LDB(dst, b, h) do { _Pragma("unroll") for (int n = 0; n < 2; ++n) _Pragma("unroll") for (int k = 0; k < 2; ++k) dst[n][k] = *(const PG8_LAS bf16x8*)(lds + PG8_SB(b, h) + boff + n * 2048 + k * 1024); } while (0)
#define PG8_MMA(ai, bj, At, Bt) do { __builtin_amdgcn_s_setprio(1); _Pragma("unroll") for (int m = 0; m < 4; ++m) _Pragma("unroll") for (int n = 0; n < 2; ++n) _Pragma("unroll") for (int k = 0; k < 2; ++k) \
        acc[ai][bj][m][n] = __builtin_amdgcn_mfma_f32_16x16x32_bf16(Bt[n][k], At[m][k], acc[ai][bj][m][n], 0, 0, 0); __builtin_amdgcn_s_setprio(0); } while (0)
#define PG8_WAIT_V(n) asm volatile("s_waitcnt vmcnt(" #n ")" ::: "memory")
#define PG8_WAIT_L(n) asm volatile("s_waitcnt lgkmcnt(" #n ")" ::: "memory")
#define PG8_BAR __builtin_amdgcn_s_barrier()
#define PG8_SCHED __builtin_amdgcn_sched_barrier(0)
    Unit cur, nxt; int ui = 0;
    if (!S.next(0, cur)) return;
    f32x4 acc[2][2][4][2];
#pragma unroll
    for (int a = 0; a < 2; ++a)
#pragma unroll
        for (int b = 0; b < 2; ++b)
#pragma unroll
            for (int m = 0; m < 4; ++m)
#pragma unroll
                for (int n = 0; n < 2; ++n) acc[a][b][m][n] = (f32x4){0.f, 0.f, 0.f, 0.f};
    bf16x8 At[4][2], B0[2][2], B1[2][2];
    const char* cA = (const char*)g.A + (size_t)cur.pm * tstepA; const char* cB = (const char*)g.Bt + (size_t)cur.pn * tstepB;
    PG8_STAGE(PG8_SB(0, 0), cB, voffB); PG8_STAGE(PG8_SB(0, 1), cB + hstepB, voffB); PG8_STAGE(PG8_SA(0, 0), cA, voffA); PG8_STAGE(PG8_SA(0, 1), cA + hstepA, voffA);
    if (wr == 1) PG8_BAR;
    PG8_WAIT_V(2); PG8_BAR;
    PG8_STAGE(PG8_SB(1, 0), cB + kstep, voffB); PG8_STAGE(PG8_SA(1, 0), cA + kstep, voffA); PG8_STAGE(PG8_SB(1, 1), cB + hstepB + kstep, voffB);
    PG8_WAIT_V(6); PG8_BAR;
    for (;;) {
        const bool has_next = S.next(ui + 1, nxt);
        const char* nA = has_next ? (const char*)g.A + (size_t)nxt.pm * tstepA : cA; const char* nB = has_next ? (const char*)g.Bt + (size_t)nxt.pn * tstepB : cB;
        for (int t = 0; t < nt; t += 2) {
            const bool last = (t == nt - 2);
            const char* a1 = cA + (size_t)(t + 1) * kstep;
            const char* a2 = last ? nA : cA + (size_t)(t + 2) * kstep; const char* b2 = last ? nB : cB + (size_t)(t + 2) * kstep;
            const char* a3 = a2 + kstep; const char* b3 = b2 + kstep;
            if constexpr (Epi::KHOOK) E.khook(acc, cur, t, wr, wc, fr, fq);
            PG8_LDB(B0, 0, 0); PG8_LDB(B1, 0, 1); PG8_SCHED; PG8_LDA(At, 0, 0); PG8_STAGE(PG8_SA(1, 1), a1 + hstepA, voffA);
            PG8_WAIT_V(8); PG8_WAIT_L(0); PG8_BAR; PG8_MMA(0, 0, At, B0); PG8_MMA(0, 1, At, B1); PG8_BAR; PG8_SCHED;
            PG8_LDA(At, 0, 1); PG8_STAGE(PG8_SB(0, 0), b2, voffB); PG8_STAGE(PG8_SB(0, 1), b2 + hstepB, voffB); PG8_STAGE(PG8_SA(0, 0), a2, voffA);
            PG8_WAIT_V(8); PG8_WAIT_L(0); PG8_BAR; PG8_MMA(1, 0, At, B0); PG8_MMA(1, 1, At, B1); PG8_BAR; PG8_SCHED;
            PG8_LDB(B0, 1, 0); PG8_LDB(B1, 1, 1); PG8_SCHED; PG8_LDA(At, 1, 0); PG8_STAGE(PG8_SA(0, 1), a2 + hstepA, voffA);
            PG8_WAIT_V(8); PG8_WAIT_L(0); PG8_BAR; PG8_MMA(0, 0, At, B0); PG8_MMA(0, 1, At, B1); PG8_BAR; PG8_SCHED;
            PG8_LDA(At, 1, 1); PG8_STAGE(PG8_SB(1, 0), b3, voffB); PG8_STAGE(PG8_SB(1, 1), b3 + hstepB, voffB); PG8_STAGE(PG8_SA(1, 0), a3, voffA);
            PG8_WAIT_V(8); PG8_WAIT_L(0); PG8_BAR; PG8_MMA(1, 0, At, B0); PG8_MMA(1, 1, At, B1); PG8_BAR; PG8_SCHED;
        }
        if constexpr (ALIGN_EPI) { if (wr == 0) PG8_BAR; }
        E(acc, cur, wr, wc, fr, fq);
        if (!has_next) break;
#pragma unroll
        for (int a = 0; a < 2; ++a)
#pragma unroll
            for (int b = 0; b < 2; ++b)
#pragma unroll
                for (int m = 0; m < 4; ++m)
#pragma unroll
                    for (int n = 0; n < 2; ++n) acc[a][b][m][n] = (f32x4){0.f, 0.f, 0.f, 0.f};
        cur = nxt; cA = nA; cB = nB; ++ui;
        if constexpr (ALIGN_EPI) { if (wr == 1) PG8_BAR; }
    }
    PG8_WAIT_V(0);
    if constexpr (!ALIGN_EPI) { if (wr == 0) PG8_BAR; }
    PG8_BAR;
#undef PG8_SA
#undef PG8_SB
#undef PG8_STAGE
#undef PG8_LDA
#undef PG8_LDB
#undef PG8_MMA
#undef PG8_WAIT_V
#undef PG8_WAIT_L
#undef PG8_BAR
#undef PG8_SCHED
}
}

constexpr int NWAVES = 8;
constexpr int DM = 1024, MP = 16384, MS = 512, MT = MP + MS;
constexpr int SEQ = 2048, DSEQ = 64, DEPTH = 2, NB = 8;
constexpr int D_IN = 8720;
constexpr int ZP = 5632;
constexpr int CA = 0, CU = 512, CVB = 1024, CQ = 1536, CK = 2048, CGC = 2560, CGA = 3584, CGB = 4096, CVC = 4608, CY = 3584;
constexpr int N1A = 5632, N1B = 3072, N1 = N1A + N1B;
constexpr float EPS = 1e-6f;
constexpr size_t O_YP = 0, O_YS = 16777216, O_PP = 17301504, O_GP = 17424384, O_PS = 19521536, O_GS = 19644416, O_SV = 21741568, O_END = 22265856;

constexpr size_t MiB = 1u << 20;
constexpr size_t WS_CTL = 0, CTL_ZERO_BYTES = 64 * 1024;
constexpr size_t WS_MOD = 1 * MiB;
constexpr size_t WS_SGUW = 1 * MiB + 512 * 1024;
constexpr size_t WS_PWT = 1 * MiB + 768 * 1024;
constexpr size_t WS_ZLR = 2 * MiB;
constexpr size_t WS_WLR = 3 * MiB + 512 * 1024;
constexpr size_t WS_WLRB = 3 * MiB + 640 * 1024;
constexpr size_t WS_W1 = 4 * MiB;
constexpr size_t WS_WCAT = 38 * MiB;
constexpr size_t WS_WOUT = 46 * MiB;
constexpr size_t WS_XN = 50 * MiB;
constexpr size_t WS_Z = 83 * MiB;
constexpr size_t WS_ABUF = WS_Z + (size_t)MT * ZP * 2;
constexpr size_t WS_DEC = WS_ABUF + (size_t)1056 * 5120;
constexpr size_t WS_END = WS_DEC + (size_t)1056 * 512;
static_assert(WS_ZLR + (size_t)MT * 16 * 4 <= WS_WLR && WS_W1 + (size_t)2 * N1 * 1024 * 2 <= WS_WCAT && WS_WCAT + (size_t)2 * 1024 * 2048 * 2 <= WS_WOUT && WS_WOUT + (size_t)2 * 1024 * 1024 * 2 <= WS_XN && WS_XN + (size_t)MT * 1024 * 2 <= WS_Z, "ws map");
constexpr int CW_TMO = 0, CW_BAR = 4096;

constexpr int RING_BYTES = 131072, LDSCTL_OFF = RING_BYTES, MISC_OFF = LDSCTL_OFF + 320, LDS_BYTES = 147456;

#define GAS __attribute__((address_space(1)))
#define LAS __attribute__((address_space(3)))
typedef unsigned short bf16;
typedef unsigned v4u __attribute__((ext_vector_type(4)));
typedef unsigned v2u __attribute__((ext_vector_type(2)));
typedef float f32x4 __attribute__((ext_vector_type(4)));
typedef GAS unsigned gu32;
#define RLX_AGENT __ATOMIC_RELAXED, __HIP_MEMORY_SCOPE_AGENT
#define LDS_WAIT() asm volatile("s_waitcnt lgkmcnt(0)" ::: "memory")
__device__ __forceinline__ unsigned f2bf(float f) { unsigned u = __builtin_bit_cast(unsigned, f); return (u + 0x7fffu + ((u >> 16) & 1u)) >> 16; }
__device__ __forceinline__ unsigned pk2(float lo, float hi) { return f2bf(lo) | (f2bf(hi) << 16); }
__device__ __forceinline__ float bf2f(bf16 v) { return __uint_as_float((unsigned)v << 16); }
__device__ __forceinline__ float siluf_(float x) { return x * __builtin_amdgcn_rcpf(1.0f + __expf(-x)); }

#define XB_TMO      128
#define XB_XCNT(j)  (256  + 64 * (j))
#define XB_XSUB(j)  (1280 + 64 * (j))
#define XB_XGEN(j)  (2304 + 64 * (j))
#define XB_TOP      3328
#define XB_TOPGEN   3392
#define XCD_BAR_WORDS 3456
#define XB_SPIN_CAP (1u << 18)
__device__ __forceinline__ unsigned xb_ld(unsigned* p)              { return __hip_atomic_load(p, __ATOMIC_RELAXED, __HIP_MEMORY_SCOPE_AGENT); }
__device__ __forceinline__ unsigned xb_add(unsigned* p, unsigned v) { return __hip_atomic_fetch_add(p, v, __ATOMIC_RELAXED, __HIP_MEMORY_SCOPE_AGENT); }
__device__ __forceinline__ unsigned xb_xcc_id() { return (unsigned)__builtin_amdgcn_s_getreg((3 << 11) | 20) & 0xFu; }
#define XB_SPIN(cond, bar) do { unsigned _sp = 0; while (cond) { __builtin_amdgcn_s_sleep(1); \
    if ((++_sp & 255u) == 0u) { if (xb_ld(&(bar)[XB_TMO])) break; if (_sp > XB_SPIN_CAP) { atomicAdd(&(bar)[XB_TMO], 1u); break; } } } } while (0)
struct XcdBarrier { unsigned* bar; unsigned x; volatile LAS unsigned* st; };
__device__ __forceinline__ XcdBarrier xcd_barrier_post(unsigned* bar, volatile LAS unsigned* st) {
    XcdBarrier b; b.bar = bar; b.x = xb_xcc_id(); b.st = st;
    if (threadIdx.x == 0) (void)xb_add(&bar[XB_XCNT(b.x)], 1u);
    return b;
}
__device__ __forceinline__ void xcd_barrier_complete(unsigned* bar, unsigned x, unsigned& nloc, unsigned& nx) {
    const unsigned G = gridDim.x * gridDim.y * gridDim.z;
    unsigned sum, cnt, mine, sp = 0u;
    for (;;) {
        sum = 0u; cnt = 0u; mine = 0u;
#pragma unroll
        for (unsigned j = 0; j < 16; ++j) { const unsigned c = xb_ld(&bar[XB_XCNT(j)]); sum += c; cnt += (c > 0u) ? 1u : 0u; mine = (j == x) ? c : mine; }
        if (sum == G) break;
        __builtin_amdgcn_s_sleep(1);
        if ((++sp & 255u) == 0u) { if (xb_ld(&bar[XB_TMO])) break; if (sp > XB_SPIN_CAP) { atomicAdd(&bar[XB_TMO], 1u); break; } }
    }
    nloc = mine > 0u ? mine : 1u; nx = cnt > 0u ? cnt : 1u;
}
__device__ __forceinline__ void xcd_barrier(const XcdBarrier& b) {
    asm volatile("s_waitcnt vmcnt(0)" ::: "memory");
    __syncthreads();
    if (threadIdx.x == 0) {
        unsigned* bar = b.bar;
        __builtin_amdgcn_s_waitcnt(0);
        unsigned nloc = b.st[0], nx = b.st[1];
        if (nloc == 0u) { xcd_barrier_complete(bar, b.x, nloc, nx); b.st[0] = nloc; b.st[1] = nx; }
        const unsigned old = xb_add(&bar[XB_XSUB(b.x)], 1u);
        const unsigned gen = old / nloc;
        if (old + 1u == (gen + 1u) * nloc) {
            __builtin_amdgcn_fence(__ATOMIC_RELEASE, "agent");
            asm volatile("s_waitcnt vmcnt(0)" ::: "memory");
            const unsigned og = xb_add(&bar[XB_TOP], 1u);
            const unsigned tg = og / nx;
            if (og + 1u == (tg + 1u) * nx) xb_add(&bar[XB_TOPGEN], 1u);
            else XB_SPIN(xb_ld(&bar[XB_TOPGEN]) == tg, bar);
            __builtin_amdgcn_fence(__ATOMIC_ACQUIRE, "agent");
            xb_add(&bar[XB_XGEN(b.x)], 1u);
            asm volatile("s_waitcnt vmcnt(0)" ::: "memory");
        } else {
            XB_SPIN(xb_ld(&bar[XB_XGEN(b.x)]) == gen, bar);
            __builtin_amdgcn_fence(__ATOMIC_ACQUIRE, "agent");
            asm volatile("s_waitcnt vmcnt(0)" ::: "memory");
        }
    }
    __syncthreads();
}

__device__ __forceinline__ int opq(int x) { asm volatile("" : "+v"(x)); return x; }
struct Frame {
    LAS unsigned char* lds;
    int tid, lane, wave, vcu, G;
};
__device__ __forceinline__ float wave_sum(float v) {
    v += __int_as_float(__builtin_amdgcn_ds_swizzle(__float_as_int(v), 0x041F));
    v += __int_as_float(__builtin_amdgcn_ds_swizzle(__float_as_int(v), 0x081F));
    v += __int_as_float(__builtin_amdgcn_ds_swizzle(__float_as_int(v), 0x101F));
    v += __int_as_float(__builtin_amdgcn_ds_swizzle(__float_as_int(v), 0x201F));
    v += __int_as_float(__builtin_amdgcn_ds_swizzle(__float_as_int(v), 0x401F));
    const auto rr = __builtin_amdgcn_permlane32_swap(__float_as_uint(v), __float_as_uint(v), false, false);
    return __uint_as_float(rr[0]) + __uint_as_float(rr[1]);
}
enum { I_XP = 0, I_XS, I_SPOOL, I_SGLA, I_CP, I_CS, I_ADAW, I_ADAB, I_PREG, I_POSTG, I_WIN, I_POOLW, I_POOLS, I_SGUG, I_SGUW, I_SGUB, I_WA2, I_BA, I_GLAG, I_WOA, I_WOB, I_WOC, I_WOUT, N_IN };
struct Args { const float* in[N_IN]; float* out; unsigned char* ws; int ph_lo, ph_hi, li, pad; };

__device__ __forceinline__ void transpose_item(const float* src, int ldsrc, bf16* dst, int ldd, LAS float* scr, int lane) {
    f32x4 v[8];
    const int kr = lane >> 3, nq = lane & 7;
#pragma unroll
    for (int i = 0; i < 8; ++i) v[i] = *(const GAS f32x4*)(src + (size_t)(8 * i + kr) * ldsrc + 4 * nq);
#pragma unroll
    for (int i = 0; i < 8; ++i) { LAS float* p = scr + (8 * i + kr) * 33 + 4 * nq; p[0] = v[i].x; p[1] = v[i].y; p[2] = v[i].z; p[3] = v[i].w; }
    LDS_WAIT(); asm volatile("" ::: "memory");
    const int c = lane & 7;
#pragma unroll
    for (int j = 0; j < 4; ++j) { const int n = (lane >> 3) + 8 * j; const LAS float* s = scr + (8 * c) * 33 + n;
        v4u o; o.x = pk2(s[0 * 33], s[1 * 33]); o.y = pk2(s[2 * 33], s[3 * 33]); o.z = pk2(s[4 * 33], s[5 * 33]); o.w = pk2(s[6 * 33], s[7 * 33]);
        *(GAS v4u*)(dst + (size_t)n * ldd + 8 * c) = o; }
    LDS_WAIT(); asm volatile("" ::: "memory");
}
__device__ __forceinline__ int w1_src_col(int n) {
    if (n < 512) return n;
    if (n < 1024) return 1024 + (n - 512);
    if (n < 1536) return 1536 + (n - 1024);
    if (n < 2048) return 2560 + (n - 1536);
    if (n < 2560) return 3072 + (n - 2048);
    if (n < 3584) return 4608 + (n - 2560);
    if (n < 4096) return 512 + (n - 3584);
    if (n < 4608) return 2048 + (n - 4096);
    if (n < 5632) return 3584 + (n - 4608);
    return 5648 + (n - 5632);
}
__device__ __forceinline__ int batch_of_row(int m) { return m < MP ? (m >> 11) : 8 + ((m - MP) >> 6); }

__device__ __forceinline__ void xn_rows2(const float* xrow0, const float* g, const float* mod  , bf16* orow0, int lane) {
    f32x4 v[2][4]; float s[2];
#pragma unroll
    for (int r = 0; r < 2; ++r)
#pragma unroll
        for (int j = 0; j < 4; ++j) v[r][j] = ((const GAS f32x4*)(xrow0 + (size_t)r * DM) + lane)[64 * j];
#pragma unroll
    for (int r = 0; r < 2; ++r) { float a = 0.f;
#pragma unroll
        for (int j = 0; j < 4; ++j) a += (v[r][j].x * v[r][j].x + v[r][j].y * v[r][j].y) + (v[r][j].z * v[r][j].z + v[r][j].w * v[r][j].w);
        s[r] = a; }
    s[0] = wave_sum(s[0]); s[1] = wave_sum(s[1]);
#pragma unroll
    for (int j = 0; j < 4; ++j) {
        const int c = 4 * lane + 256 * j;
        const f32x4 gg = *(const f32x4*)(g + c), sh = *(const f32x4*)(mod + c), sc = *(const f32x4*)(mod + 1024 + c);
#pragma unroll
        for (int r = 0; r < 2; ++r) {
            const float rstd = 1.0f / sqrtf(s[r] * (1.f / DM) + EPS);
            const f32x4 h = (v[r][j] * rstd) * gg * (sc + 1.0f) + sh;
            ((GAS unsigned long long*)(orow0 + (size_t)r * DM) + lane)[64 * j] = (unsigned long long)pk2(h.x, h.y) | ((unsigned long long)pk2(h.z, h.w) << 32);
        }
    }
}

constexpr int NPH = 18;

__global__ void __launch_bounds__(NWAVES * 64, 2) mk_fwd(Args args) {
    extern __shared__ __attribute__((aligned(16))) unsigned char lds[];
    Frame F;
    F.lds = (LAS unsigned char*)lds;
    volatile LAS unsigned* MISC = (volatile LAS unsigned*)(F.lds + MISC_OFF);
    F.tid = threadIdx.x; F.lane = F.tid & 63; F.wave = __builtin_amdgcn_readfirstlane(F.tid >> 6);
    F.G = gridDim.x; { const int bx = blockIdx.x; F.vcu = (F.G % 8 == 0) ? (bx % 8) * (F.G / 8) + bx / 8 : bx; }
    typedef const Args __attribute__((address_space(4)))* KArgs;
    KArgs ka = (KArgs)__builtin_amdgcn_kernarg_segment_ptr();
    unsigned char* ws = args.ws;
    gu32* ctl = (gu32*)(ws + WS_CTL);
    for (int u = F.tid; u < (LDS_BYTES - LDSCTL_OFF) / 4; u += NWAVES * 64) ((LAS unsigned*)(F.lds + LDSCTL_OFF))[u] = 0u;
    __syncthreads();
    XcdBarrier bar; bar.bar = (unsigned*)(ctl + CW_BAR); bar.x = 0; bar.st = nullptr;
    if (MK_N_LAUNCHES == 1) bar = xcd_barrier_post((unsigned*)(ctl + CW_BAR), MISC + 8);
#define GRID_BAR() do { if (MK_N_LAUNCHES == 1) { xcd_barrier(bar); if (REPS(15) == 2) xcd_barrier(bar); } } while (0)
    const int lo = args.ph_lo, hi = args.ph_hi;
#ifndef ABLMASK
#define ABLMASK 0xffff
#endif
#define IN(k) (lo <= (k) && (k) < hi)
#define PHASE_BEGIN() do { F.tid = opq((int)threadIdx.x); F.lane = F.tid & 63; unsigned long long kp_ = (unsigned long long)__builtin_amdgcn_kernarg_segment_ptr(); asm volatile("" : "+s"(kp_)); \
        ka = (KArgs)kp_; ws = ka->ws; dout = ka->out; } while (0)
#define KON(b) ((ABLMASK >> (b)) & 1)
#ifndef DUPMASK
#define DUPMASK 0
#endif
#define REPS(b) (((DUPMASK >> (b)) & 1) ? 2 : 1)
#define mod_all ((float*)(ws + WS_MOD))
#define zlr ((float*)(ws + WS_ZLR))
#define wlr_all ((float*)(ws + WS_WLR))
#define XN ((bf16*)(ws + WS_XN))
#define Z ((bf16*)(ws + WS_Z))
#define OUTF ((float*)(ws + WS_Z))
    float* dout = args.out;
    const int gw = F.vcu * NWAVES + F.wave, NGW = F.G * NWAVES;

    if (KON(0) && IN(0)) for (int rep_ = 0; rep_ < REPS(0); ++rep_) {
        PHASE_BEGIN();
        LAS float* scr = (LAS float*)(F.lds + F.wave * 16384);
        constexpr int I_W1 = (1024 / 64) * (N1 / 32);
        constexpr int I_OA = (512 / 64) * 32, I_OC = (1024 / 64) * 32, I_OUT = (1024 / 64) * 32;
        constexpr int PER_L = I_W1 + 2 * I_OA + I_OC + I_OUT;
        for (int it = gw; it < 2 * PER_L; it += NGW) {
            const int l = it / PER_L; int r = it % PER_L;
            if (r < I_W1) { const int nb = r % (N1 / 32), kb = r / (N1 / 32); const int n0 = 32 * nb, k0 = 64 * kb;
                transpose_item(ka->in[I_WIN] + (size_t)l * 1024 * D_IN + (size_t)k0 * D_IN + w1_src_col(n0), D_IN, (bf16*)(ws + WS_W1) + ((size_t)l * N1 + n0) * 1024 + k0, 1024, scr, F.lane); continue; }
            r -= I_W1;
            bf16* wcat = (bf16*)(ws + WS_WCAT) + (size_t)l * 1024 * 2048;
            if (r < I_OA) { const int nb = r % 32, kb = r / 32; transpose_item(ka->in[I_WOA] + (size_t)l * 512 * 1024 + (size_t)(64 * kb) * 1024 + 32 * nb, 1024, wcat + (size_t)(32 * nb) * 2048 + 64 * kb, 2048, scr, F.lane); continue; }
            r -= I_OA;
            if (r < I_OA) { const int nb = r % 32, kb = r / 32; transpose_item(ka->in[I_WOB] + (size_t)l * 512 * 1024 + (size_t)(64 * kb) * 1024 + 32 * nb, 1024, wcat + (size_t)(32 * nb) * 2048 + 512 + 64 * kb, 2048, scr, F.lane); continue; }
            r -= I_OA;
            if (r < I_OC) { const int nb = r % 32, kb = r / 32; transpose_item(ka->in[I_WOC] + (size_t)l * 1024 * 1024 + (size_t)(64 * kb) * 1024 + 32 * nb, 1024, wcat + (size_t)(32 * nb) * 2048 + 1024 + 64 * kb, 2048, scr, F.lane); continue; }
            r -= I_OC;
            { const int nb = r % 32, kb = r / 32; transpose_item(ka->in[I_WOUT] + (size_t)l * 1024 * 1024 + (size_t)(64 * kb) * 1024 + 32 * nb, 1024, (bf16*)(ws + WS_WOUT) + (size_t)l * 1024 * 1024 + (size_t)(32 * nb) * 1024 + 64 * kb, 1024, scr, F.lane); }
        }
        for (int i = blockIdx.x * 512 + F.tid; i < 2 * 4 * 128 * 128; i += F.G * 512) {
            const int jj = i & 127, ii = (i >> 7) & 127, lg = i >> 14;
            ((bf16*)(ws + WS_SGUW))[i] = (bf16)f2bf(jj <= ii ? ka->in[I_SGUW][i] : 0.f);
            ((bf16*)(ws + WS_PWT))[i] = (bf16)f2bf(ka->in[I_POOLW][(size_t)lg * 16384 + jj * 128 + ii]);
        }
        for (int i = blockIdx.x * 512 + F.tid; i < 2 * 16 * 1024; i += F.G * 512) { const int l = i >> 14, r = (i >> 10) & 15, k = i & 1023; ((bf16*)(ws + WS_WLRB))[i] = (bf16)f2bf(ka->in[I_WIN][(size_t)l * 1024 * D_IN + (size_t)k * D_IN + 5632 + r]); }
        for (int i = blockIdx.x * 512 + F.tid; i < 2 * 16 * 1024; i += F.G * 512) { const int l = i >> 14, r = (i >> 10) & 15, k = i & 1023; wlr_all[i] = ka->in[I_WIN][(size_t)l * 1024 * D_IN + (size_t)k * D_IN + 5632 + r]; }
        __syncthreads();
        LAS float* sc = (LAS float*)F.lds;
        LAS float* part = (LAS float*)(F.lds + 65536);
        for (int i = F.tid; i < 16 * 1024; i += 512) { const int bi = i >> 10, k = i & 1023; const float cv = bi < 8 ? ka->in[I_CP][bi * 1024 + k] : ka->in[I_CS][(bi - 8) * 1024 + k]; sc[i] = siluf_(cv); }
        __syncthreads();
        for (int it = (F.vcu + 64) % F.G; it < 2 * 96; it += F.G) {
            const int l = it / 96, j0 = (it % 96) * 32, col = F.tid & 31, ks = F.tid >> 5;
            float a[16];
#pragma unroll
            for (int b = 0; b < 16; ++b) a[b] = 0.f;
            const float* wp = ka->in[I_ADAW] + (size_t)l * 1024 * 3072 + j0 + col;
#pragma unroll 16
            for (int k = ks * 64; k < ks * 64 + 64; ++k) {
                const float w = wp[(size_t)k * 3072];
#pragma unroll
                for (int b = 0; b < 16; ++b) a[b] += sc[b * 1024 + k] * w;
            }
#pragma unroll
            for (int b = 0; b < 16; ++b) part[(ks * 16 + b) * 32 + col] = a[b];
            __syncthreads();
            { const int b = F.tid >> 5, j = F.tid & 31; float s = 0.f;
#pragma unroll
                for (int w = 0; w < 16; ++w) s += part[(w * 16 + b) * 32 + j];
                mod_all[((size_t)l * 16 + b) * 3072 + j0 + j] = s + ka->in[I_ADAB][l * 3072 + j0 + j]; }
            __syncthreads();
        }
        GRID_BAR();
    }
    if (KON(1) && IN(1)) for (int rep_ = 0; rep_ < REPS(1); ++rep_) {
        PHASE_BEGIN();
        for (int m = 2 * gw; m < MT; m += 2 * NGW) {
            const float* xrow = m < MP ? ka->in[I_XP] + (size_t)m * DM : ka->in[I_XS] + (size_t)(m - MP) * DM;
            xn_rows2(xrow, ka->in[I_PREG], mod_all + (size_t)batch_of_row(m) * 3072, XN + (size_t)m * DM, F.lane);
        }
        GRID_BAR();
    }
    for (int l = 0; l < DEPTH; ++l) {
        const int pb = 2 + 8 * l;
        const float* mod_l = mod_all + (size_t)l * 16 * 3072;
        const bf16* W1 = (const bf16*)(ws + WS_W1) + (size_t)l * N1 * 1024;
        if (KON(2) && IN(pb + 0)) {
        PHASE_BEGIN();
            {
                const bf16* wl = (const bf16*)(ws + WS_WLRB) + (size_t)l * 16 * 1024;
                const int fr = F.lane & 15, fq = F.lane >> 4;
                for (int tile = gw; tile < MT / 16; tile += NGW) {
                    const bf16* ap = XN + (size_t)(16 * tile + fr) * DM + 8 * fq; const bf16* bp = wl + (size_t)fr * 1024 + 8 * fq;
                    pg8::f32x4 acc = {0.f, 0.f, 0.f, 0.f};
#pragma unroll 8
                    for (int s = 0; s < 32; ++s) {
                        const pg8::bf16x8 af = *(const GAS pg8::bf16x8*)(ap + 32 * s), bf = *(const GAS pg8::bf16x8*)(bp + 32 * s);
                        acc = __builtin_amdgcn_mfma_f32_16x16x32_bf16(af, bf, acc, 0, 0, 0);
                    }
#pragma unroll
                    for (int e = 0; e < 4; ++e) zlr[(size_t)(16 * tile + 4 * fq + e) * 16 + fr] = acc[e];
                }
            }
            __syncthreads();
            pg8::Gemm g{XN, W1, 1024, 1024, 1024}; pg8::StaticOrder S; S.init(MT / 256, N1A / 256, F.G, (int)blockIdx.x);
            pg8::EpiZ E{Z, ZP, dout + O_PP + (size_t)l * NB * 15 * 512, dout + O_PS + (size_t)l * NB * 15 * 512};
            for (int rep_ = 0; rep_ < REPS(2); ++rep_) pg8::gemm_phase<pg8::EpiZ, pg8::StaticOrder, true>(F.lds, g, S, E);
            GRID_BAR();
        }
        if (KON(3) && IN(pb + 1)) {
        PHASE_BEGIN();
            {
                LAS float* at = (LAS float*)F.lds;
                LAS unsigned char* DT = F.lds + 79 * 128 * 4;
                const int fr = F.lane & 15, fq = F.lane >> 4;
                for (int it = F.vcu; it < (MT / 64) * 4; it += F.G) {
                    const int tile = it >> 2, g = it & 3, w = 2 << g;
                    const int m0 = tile * 64; const bool smp = m0 >= MP;
                    const int bb = smp ? ((m0 - MP) >> 6) : (m0 >> 11), t0 = smp ? 0 : (m0 & 2047), pos0 = smp ? SEQ : 0;
                    for (int i = F.tid; i < 79 * 16; i += 512) {
                        const int ri = i >> 4, p = i & 15, t = t0 - 15 + ri; f32x4 v0 = {0.f, 0.f, 0.f, 0.f}, v1 = v0;
                        if (t >= 0) { const v4u raw = *(const GAS v4u*)(Z + (size_t)(m0 - 15 + ri) * ZP + CA + g * 128 + 8 * p);
                            v0 = (f32x4){pg8::bflo(raw.x), pg8::bfhi(raw.x), pg8::bflo(raw.y), pg8::bfhi(raw.y)}; v1 = (f32x4){pg8::bflo(raw.z), pg8::bfhi(raw.z), pg8::bflo(raw.w), pg8::bfhi(raw.w)}; }
                        else if (smp) { const float* sp = ka->in[I_SPOOL] + (((size_t)l * NB + bb) * 15 + (15 + t)) * 512 + g * 128 + 8 * p; v0 = *(const f32x4*)sp; v1 = *(const f32x4*)(sp + 4); }
                        *(LAS f32x4*)(at + ri * 128 + 8 * p) = v0; *(LAS f32x4*)(at + ri * 128 + 8 * p + 4) = v1;
                    }
                    __syncthreads();
                    {
                        const int tt = F.tid >> 3, c0 = 16 * (F.tid & 7);
                        const int pos = pos0 + t0 + tt; const float rc = 1.0f / (float)((pos + 1) < w ? (pos + 1) : w);
                        f32x4 s[4];
#pragma unroll
                        for (int q = 0; q < 4; ++q) s[q] = (f32x4){0.f, 0.f, 0.f, 0.f};
                        for (int k = 0; k < w; ++k) {
#pragma unroll
                            for (int q = 0; q < 4; ++q) s[q] += *(const LAS f32x4*)(at + (tt + 15 - k) * 128 + c0 + 4 * q);
                        }
                        unsigned pk[8];
#pragma unroll
                        for (int q = 0; q < 4; ++q) { const f32x4 a0 = *(const LAS f32x4*)(at + (tt + 15) * 128 + c0 + 4 * q); const f32x4 dd = s[q] * rc - a0; pk[2 * q] = pk2(dd.x, dd.y); pk[2 * q + 1] = pk2(dd.z, dd.w); }
                        *(LAS v4u*)(DT + tt * 272 + c0 * 2) = (v4u){pk[0], pk[1], pk[2], pk[3]}; *(LAS v4u*)(DT + tt * 272 + c0 * 2 + 16) = (v4u){pk[4], pk[5], pk[6], pk[7]};
                    }
                    __syncthreads();
                    {
                        const int ctw = F.wave;
                        const bf16* pwt = (const bf16*)(ws + WS_PWT) + ((size_t)(l * 4 + g) * 128 + 16 * ctw + fr) * 128 + 8 * fq;
                        pg8::bf16x8 pwf[4];
#pragma unroll
                        for (int s2 = 0; s2 < 4; ++s2) pwf[s2] = *(const GAS pg8::bf16x8*)(pwt + 32 * s2);
                        const f32x4 ps = *(const f32x4*)(ka->in[I_POOLS] + l * 512 + g * 128 + 16 * ctw + 4 * fq);
                        v2u graw[4];
#pragma unroll
                        for (int rt = 0; rt < 4; ++rt) graw[rt] = *(const GAS v2u*)(Z + (size_t)(m0 + 16 * rt + fr) * ZP + CGA + g * 128 + 16 * ctw + 4 * fq);
#pragma unroll
                        for (int rt = 0; rt < 4; ++rt) {
                            pg8::f32x4 acc = {0.f, 0.f, 0.f, 0.f};
#pragma unroll
                            for (int s2 = 0; s2 < 4; ++s2) { const pg8::bf16x8 df = *(const LAS pg8::bf16x8*)(DT + (16 * rt + fr) * 272 + (32 * s2 + 8 * fq) * 2); acc = __builtin_amdgcn_mfma_f32_16x16x32_bf16(pwf[s2], df, acc, 0, 0, 0); }
                            bf16* p = Z + (size_t)(m0 + 16 * rt + fr) * ZP + CGA + g * 128 + 16 * ctw + 4 * fq;
                            v2u o; o.x = pk2(acc[0] * ps.x * siluf_(pg8::bflo(graw[rt].x)), acc[1] * ps.y * siluf_(pg8::bfhi(graw[rt].x))); o.y = pk2(acc[2] * ps.z * siluf_(pg8::bflo(graw[rt].y)), acc[3] * ps.w * siluf_(pg8::bfhi(graw[rt].y)));
                            *(GAS v2u*)p = o;
                        }
                    }
                    __syncthreads();
                }
            }
            {
                LAS unsigned char* VN = F.lds;
                LAS unsigned char* WT = F.lds + 128 * 272;
                const int fr = F.lane & 15, fq = F.lane >> 4;
                for (int it = (F.vcu + 224) % F.G; it < 136 * 4; it += F.G) {
                    const int ch = it >> 2, g = it & 3;
                    const bool smp = ch >= 128; const int L = smp ? 64 : 128, m0 = smp ? MP + (ch - 128) * 64 : ch * 128;
                    for (int i = F.tid; i < 2048; i += 512) { const int row = i >> 4, p = i & 15;
                        *(LAS v4u*)(WT + row * 272 + p * 16) = *(const GAS v4u*)((const bf16*)(ws + WS_SGUW) + ((size_t)(l * 4 + g) * 128 + row) * 128 + 8 * p); }
                    {
                        const int c0 = 8 * (F.lane & 15);
                        const f32x4 g0 = *(const f32x4*)(ka->in[I_SGUG] + l * 512 + g * 128 + c0), g1 = *(const f32x4*)(ka->in[I_SGUG] + l * 512 + g * 128 + c0 + 4);
                        for (int r0 = 0; 8 * r0 < L; r0 += 4) {
                            v4u rawv[4];
#pragma unroll
                            for (int r = 0; r < 4; ++r) rawv[r] = *(const GAS v4u*)(Z + (size_t)(m0 + F.wave + 8 * (r0 + r)) * ZP + CVB + 8 * F.lane);
#pragma unroll
                            for (int r = 0; r < 4; ++r) {
                                const int j = F.wave + 8 * (r0 + r); const v4u raw = rawv[r];
                                float x[8]; x[0] = pg8::bflo(raw.x); x[1] = pg8::bfhi(raw.x); x[2] = pg8::bflo(raw.y); x[3] = pg8::bfhi(raw.y); x[4] = pg8::bflo(raw.z); x[5] = pg8::bfhi(raw.z); x[6] = pg8::bflo(raw.w); x[7] = pg8::bfhi(raw.w);
                                float s = 0.f;
#pragma unroll
                                for (int e = 0; e < 8; ++e) s += x[e];
                                const float mu = wave_sum(s) * (1.f / 512.f); float q = 0.f;
#pragma unroll
                                for (int e = 0; e < 8; ++e) { x[e] -= mu; q += x[e] * x[e]; }
                                const float rstd = 1.0f / sqrtf(wave_sum(q) * (1.f / 512.f) + EPS);
                                if ((F.lane >> 4) == g) {
                                    const f32x4 y0 = (f32x4){x[0], x[1], x[2], x[3]} * rstd * g0, y1 = (f32x4){x[4], x[5], x[6], x[7]} * rstd * g1;
                                    *(LAS v4u*)(VN + j * 272 + c0 * 2) = (v4u){pk2(y0.x, y0.y), pk2(y0.z, y0.w), pk2(y1.x, y1.y), pk2(y1.z, y1.w)};
                                    if (smp) { float* dp = dout + O_SV + (((size_t)l * NB + (ch - 128)) * 64 + j) * 512 + g * 128 + c0; *(f32x4*)dp = y0; *(f32x4*)(dp + 4) = y1; }
                                }
                            }
                        }
                    }
                    __syncthreads();
                    {
                        const int ctw = F.wave;
                        pg8::bf16x8 vfr[4];
#pragma unroll
                        for (int s2 = 0; s2 < 4; ++s2) {
                            if (32 * s2 < L) {
                                typedef short v4i16_t __attribute__((ext_vector_type(4)));
                                const int q_ = fr >> 2, p_ = F.lane & 3;
                                const v4i16_t lo = __builtin_amdgcn_ds_read_tr16_b64_v4i16((LAS v4i16_t*)(VN + (32 * s2 + 8 * fq + q_) * 272 + (16 * ctw + 4 * p_) * 2));
                                const v4i16_t hi = __builtin_amdgcn_ds_read_tr16_b64_v4i16((LAS v4i16_t*)(VN + (32 * s2 + 8 * fq + 4 + q_) * 272 + (16 * ctw + 4 * p_) * 2));
                                vfr[s2] = (pg8::bf16x8){lo[0], lo[1], lo[2], lo[3], hi[0], hi[1], hi[2], hi[3]};
                            } else vfr[s2] = (pg8::bf16x8){0, 0, 0, 0, 0, 0, 0, 0};
                        }
                        const size_t rb0 = (size_t)(m0 + fr) * ZP + g * 128 + 16 * ctw + 4 * fq;
                        const float* bp = ka->in[I_SGUB] + (l * 4 + g) * 128 + fr;
                        v2u uc = *(const GAS v2u*)(Z + rb0 + CU), gc = *(const GAS v2u*)(Z + rb0 + CGB); float bc = bp[0];
#pragma unroll
                        for (int rt = 0; rt < 8; ++rt) {
                            if (16 * rt < L) {
                                v2u un = uc, gn = gc; float bn = bc;
                                if (16 * (rt + 1) < L) { const size_t rbn = rb0 + (size_t)(16 * (rt + 1)) * ZP; un = *(const GAS v2u*)(Z + rbn + CU); gn = *(const GAS v2u*)(Z + rbn + CGB); bn = bp[16 * (rt + 1)]; }
                                pg8::f32x4 acc = {0.f, 0.f, 0.f, 0.f};
#pragma unroll
                                for (int s2 = 0; s2 < 4; ++s2) if (s2 <= (rt >> 1)) { const pg8::bf16x8 wf = *(const LAS pg8::bf16x8*)(WT + (16 * rt + fr) * 272 + (32 * s2 + 8 * fq) * 2); acc = __builtin_amdgcn_mfma_f32_16x16x32_bf16(vfr[s2], wf, acc, 0, 0, 0); }
                                v2u o; o.x = pk2(pg8::bflo(uc.x) * (acc[0] + bc) * siluf_(pg8::bflo(gc.x)), pg8::bfhi(uc.x) * (acc[1] + bc) * siluf_(pg8::bfhi(gc.x)));
                                o.y = pk2(pg8::bflo(uc.y) * (acc[2] + bc) * siluf_(pg8::bflo(gc.y)), pg8::bfhi(uc.y) * (acc[3] + bc) * siluf_(pg8::bfhi(gc.y)));
                                *(GAS v2u*)(Z + rb0 + (size_t)(16 * rt) * ZP + CGB) = o;
                                uc = un; gc = gn; bc = bn;
                            }
                        }
                    }
                    __syncthreads();
                }
            }
            {
                constexpr int PQ = 272;
                LAS unsigned char* QT = F.lds;
                LAS unsigned char* KT = F.lds + 64 * PQ;
                LAS float* tot = (LAS float*)(F.lds + 2 * 64 * PQ);
                const int d = F.tid & 127, tg = __builtin_amdgcn_readfirstlane(F.tid >> 7);
                for (int it = (F.vcu + 192) % F.G; it < 1056; it += F.G) {
                    const bool smp = it >= 1024; const int bh = smp ? it - 1024 : it >> 5, c = smp ? 0 : it & 31, bb = bh >> 2, h = bh & 3;
                    const int mb = (smp ? MP + bb * 64 : bb * SEQ) + c * 64;
                    float w2[16];
#pragma unroll
                    for (int r = 0; r < 16; ++r) w2[r] = ka->in[I_WA2][(size_t)l * 16 * 512 + r * 512 + h * 128 + d];
                    const float bad = ka->in[I_BA][l * 512 + h * 128 + d];
                    float bl[16], qv[16], kv[16]; float run = 0.f;
#pragma unroll
                    for (int i = 0; i < 16; ++i) {
                        const size_t m = (size_t)(mb + 16 * tg + i);
                        const float* zr = zlr + m * 16; float x = bad;
#pragma unroll
                        for (int r = 0; r < 16; ++r) x += zr[r] * w2[r];
                        const float ls = fminf(x, 0.f) - log1pf(__expf(-fabsf(x)));
                        run += ls * (1.0f / 16.0f); bl[i] = run;
                        qv[i] = bf2f(Z[m * ZP + CQ + h * 128 + d]); kv[i] = bf2f(Z[m * ZP + CK + h * 128 + d]);
                    }
                    tot[tg * 128 + d] = run;
                    asm volatile("s_waitcnt vmcnt(0)" ::: "memory");
                    __syncthreads();
                    float off = 0.f, total = 0.f;
#pragma unroll
                    for (int g2 = 0; g2 < 4; ++g2) { const float tv = tot[g2 * 128 + d]; total += tv; if (g2 < tg) off += tv; }
                    unsigned kp[8];
#pragma unroll
                    for (int i = 0; i < 16; ++i) {
                        const float b = off + bl[i]; const float eb = __expf(b);
                        const unsigned qb = f2bf(qv[i] * 0.08838834764831845f * eb), kb = f2bf(kv[i] * __expf(-b));
                        const int t = 16 * tg + i;
                        *(LAS bf16*)(QT + t * PQ + d * 2) = (bf16)qb; *(LAS bf16*)(KT + t * PQ + d * 2) = (bf16)kb;
                        Z[(size_t)(mb + t) * ZP + CQ + h * 128 + d] = (bf16)qb;
                        if (i & 1) kp[i >> 1] |= kb << 16; else kp[i >> 1] = kb;
                    }
                    {
                        bf16* kd = Z + (size_t)(mb + (d >> 1)) * ZP + CK + h * 128 + (d & 1) * 64 + 16 * tg;
                        *(v4u*)kd = (v4u){kp[0], kp[1], kp[2], kp[3]}; *(v4u*)(kd + 8) = (v4u){kp[4], kp[5], kp[6], kp[7]};
                    }
                    float* decg = (float*)(ws + WS_DEC) + (size_t)it * 128;
                    if (tg == 0) decg[d] = __expf(total);
                    __syncthreads();
                    {
                        const int lane = F.lane, rt = F.wave & 3, fr = lane & 15, fq = lane >> 4;
                        bf16* ab = (bf16*)(ws + WS_ABUF) + (size_t)it * 2560;
#pragma unroll
                        for (int cc = 0; cc < 2; ++cc) {
                            const int ct = 2 * (F.wave >> 2) + cc;
                            if (ct <= rt) {
                                pg8::f32x4 acc = {0.f, 0.f, 0.f, 0.f};
#pragma unroll
                                for (int s = 0; s < 4; ++s) {
                                    const pg8::bf16x8 kf = *(const LAS pg8::bf16x8*)(KT + (16 * ct + fr) * PQ + (32 * s + 8 * fq) * 2);
                                    const pg8::bf16x8 qf = *(const LAS pg8::bf16x8*)(QT + (16 * rt + fr) * PQ + (32 * s + 8 * fq) * 2);
                                    acc = __builtin_amdgcn_mfma_f32_16x16x32_bf16(kf, qf, acc, 0, 0, 0);
                                }
                                const int t = 16 * rt + fr, j0 = 16 * ct + 4 * fq;
                                v2u w;
                                w.x = pk2(j0 + 0 <= t ? acc[0] : 0.f, j0 + 1 <= t ? acc[1] : 0.f); w.y = pk2(j0 + 2 <= t ? acc[2] : 0.f, j0 + 3 <= t ? acc[3] : 0.f);
                                *(v2u*)(ab + (rt * (rt + 1) / 2 + ct) * 256 + fr * 16 + 4 * fq) = w;
                            }
                        }
                    }
                    __syncthreads();
                }
            }
            GRID_BAR();
        }
        if (KON(9) && IN(pb + 2)) {
        PHASE_BEGIN();
            constexpr int SB_A = 0, SB_Q = 9216, SB_KT = 26624, SB_V = 45056, SB_DEC = 50176, SB_SZ = 50688, SB_ST = 2 * SB_SZ, ST_SZ = 8704;
            constexpr int PA = 144, PQ2 = 272, PK = 144, PV = 80, PS = 272;
            const int tid = F.tid, lane = F.lane, fr = lane & 15, fq = lane >> 4;
            const int ct = F.wave & 1, rto = F.wave >> 1;
            for (int u = tid; u < 2 * SB_SZ / 16; u += 512) *(LAS v4u*)(F.lds + u * 16) = (v4u){0u, 0u, 0u, 0u};
            __syncthreads();
            for (int it = F.vcu; it < 512; it += F.G) {
                const bool smp = it >= 256; const int id = it & 255, bh = id >> 3, sl = id & 7, bb = bh >> 2, h = bh & 3;
                const int nch = smp ? 1 : 32, m0 = smp ? MP + bb * 64 : bb * SEQ, item0 = smp ? 1024 + bh : bh * 32;
                const int dvc = h * 256 + 32 * sl;
                pg8::f32x4 accS[2];
                float* sout = dout + (smp ? O_GS : O_GP) + (((size_t)l * NB + bb) * 4 + h) * 128 * 256 + 32 * sl + 16 * ct + fr;
                if (smp) {
                    const float* s0 = ka->in[I_SGLA] + (((size_t)l * NB + bb) * 4 + h) * 128 * 256 + 32 * sl + 16 * ct + fr;
#pragma unroll
                    for (int k2 = 0; k2 < 2; ++k2)
#pragma unroll
                        for (int i = 0; i < 4; ++i) accS[k2][i] = s0[(size_t)(16 * (2 * rto + k2) + 4 * fq + i) * 256];
                } else { accS[0] = (pg8::f32x4){0.f, 0.f, 0.f, 0.f}; accS[1] = accS[0]; }
                v4u rA, rQ0, rQ1, rK0, rK1, rV; float rD;
                const int a_tau = tid >> 5, a_rt = (a_tau >= 6) ? 3 : (a_tau >= 3) ? 2 : (a_tau >= 1) ? 1 : 0, a_ct = a_tau - a_rt * (a_rt + 1) / 2, a_p = tid & 31;
#define SC_LOAD(cidx) do { const int mb_ = m0 + 64 * (cidx); const size_t itm_ = (size_t)(item0 + (cidx)); \
                    if (tid < 320) rA = *(const GAS v4u*)((const bf16*)(ws + WS_ABUF) + itm_ * 2560 + tid * 8); \
                    rQ0 = *(const GAS v4u*)(Z + (size_t)(mb_ + (tid >> 4)) * ZP + CQ + h * 128 + 8 * (tid & 15)); \
                    rQ1 = *(const GAS v4u*)(Z + (size_t)(mb_ + 32 + (tid >> 4)) * ZP + CQ + h * 128 + 8 * (tid & 15)); \
                    rK0 = *(const GAS v4u*)(Z + (size_t)(mb_ + (tid >> 4)) * ZP + CK + h * 128 + 8 * (tid & 15)); \
                    rK1 = *(const GAS v4u*)(Z + (size_t)(mb_ + 32 + (tid >> 4)) * ZP + CK + h * 128 + 8 * (tid & 15)); \
                    if (tid < 256) rV = *(const GAS v4u*)(Z + (size_t)(mb_ + (tid >> 2)) * ZP + CVC + dvc + 8 * (tid & 3)); \
                    if (tid < 128) rD = ((const float*)(ws + WS_DEC))[itm_ * 128 + tid]; } while (0)
#define SC_STORE(bufi) do { LAS unsigned char* B_ = F.lds + (bufi) * SB_SZ; \
                    if (tid < 320) *(LAS v4u*)(B_ + SB_A + (16 * a_rt + (a_p >> 1)) * PA + (16 * a_ct + 8 * (a_p & 1)) * 2) = rA; \
                    *(LAS v4u*)(B_ + SB_Q + (tid >> 4) * PQ2 + (tid & 15) * 16) = rQ0; *(LAS v4u*)(B_ + SB_Q + (32 + (tid >> 4)) * PQ2 + (tid & 15) * 16) = rQ1; \
                    { const int r0_ = tid >> 4, p_ = tid & 15; \
                      *(LAS v4u*)(B_ + SB_KT + (2 * r0_ + (p_ >> 3)) * PK + (p_ & 7) * 16) = rK0; *(LAS v4u*)(B_ + SB_KT + (2 * (32 + r0_) + (p_ >> 3)) * PK + (p_ & 7) * 16) = rK1; } \
                    if (tid < 256) *(LAS v4u*)(B_ + SB_V + (tid >> 2) * PV + (tid & 3) * 16) = rV; \
                    if (tid < 128) *(LAS float*)(B_ + SB_DEC + tid * 4) = rD; } while (0)
#define SC_PUBLISH(sti) do { LAS unsigned char* S_ = F.lds + SB_ST + (sti) * ST_SZ; \
                    _Pragma("unroll") for (int k2 = 0; k2 < 2; ++k2) { v2u w_; w_.x = pk2(accS[k2][0], accS[k2][1]); w_.y = pk2(accS[k2][2], accS[k2][3]); \
                        *(LAS v2u*)(S_ + (16 * ct + fr) * PS + (16 * (2 * rto + k2) + 4 * fq) * 2) = w_; } } while (0)
                SC_LOAD(0);
                SC_STORE(0);
                SC_PUBLISH(0);
                __syncthreads();
                for (int c = 0; c < nch; ++c) {
                    const int cb = c & 1;
                    if (c + 1 < nch) SC_LOAD(c + 1);
                    asm volatile("" ::: "memory");
                    LAS unsigned char* B = F.lds + cb * SB_SZ; LAS unsigned char* ST = F.lds + SB_ST + cb * ST_SZ;
                    pg8::bf16x8 vf[2];
#pragma unroll
                    for (int s = 0; s < 2; ++s) {
                        typedef short v4i16_t __attribute__((ext_vector_type(4)));
                        const int q_ = fr >> 2, p_ = lane & 3;
                        const v4i16_t lo = __builtin_amdgcn_ds_read_tr16_b64_v4i16((LAS v4i16_t*)(B + SB_V + (32 * s + 8 * fq + q_) * PV + (16 * ct + 4 * p_) * 2));
                        const v4i16_t hi = __builtin_amdgcn_ds_read_tr16_b64_v4i16((LAS v4i16_t*)(B + SB_V + (32 * s + 8 * fq + 4 + q_) * PV + (16 * ct + 4 * p_) * 2));
                        vf[s] = (pg8::bf16x8){lo[0], lo[1], lo[2], lo[3], hi[0], hi[1], hi[2], hi[3]};
                    }
                    pg8::f32x4 ao = {0.f, 0.f, 0.f, 0.f};
#pragma unroll
                    for (int s = 0; s < 2; ++s) {
                        const pg8::bf16x8 af = *(const LAS pg8::bf16x8*)(B + SB_A + (16 * rto + fr) * PA + (32 * s + 8 * fq) * 2);
                        ao = __builtin_amdgcn_mfma_f32_16x16x32_bf16(vf[s], af, ao, 0, 0, 0);
                    }
#pragma unroll
                    for (int s = 0; s < 4; ++s) {
                        const pg8::bf16x8 sf = *(const LAS pg8::bf16x8*)(ST + (16 * ct + fr) * PS + (32 * s + 8 * fq) * 2);
                        const pg8::bf16x8 qf = *(const LAS pg8::bf16x8*)(B + SB_Q + (16 * rto + fr) * PQ2 + (32 * s + 8 * fq) * 2);
                        ao = __builtin_amdgcn_mfma_f32_16x16x32_bf16(sf, qf, ao, 0, 0, 0);
                    }
                    {
                        v2u w; w.x = pk2(ao[0], ao[1]); w.y = pk2(ao[2], ao[3]);
                        *(GAS v2u*)(Z + (size_t)(m0 + 64 * c + 16 * rto + fr) * ZP + CVC + dvc + 16 * ct + 4 * fq) = w;
                    }
#pragma unroll
                    for (int k2 = 0; k2 < 2; ++k2) {
                        const int rt = 2 * rto + k2;
#pragma unroll
                        for (int s = 0; s < 2; ++s) {
                            const pg8::bf16x8 kf = *(const LAS pg8::bf16x8*)(B + SB_KT + (16 * rt + fr) * PK + (32 * s + 8 * fq) * 2);
                            accS[k2] = __builtin_amdgcn_mfma_f32_16x16x32_bf16(kf, vf[s], accS[k2], 0, 0, 0);
                        }
                        const pg8::f32x4 dc = *(const LAS pg8::f32x4*)(B + SB_DEC + (16 * rt + 4 * fq) * 4);
                        accS[k2] = accS[k2] * dc;
                    }
                    SC_PUBLISH(cb ^ 1);
                    asm volatile("" ::: "memory");
                    if (c + 1 < nch) SC_STORE(cb ^ 1);
                    __syncthreads();
                }
#pragma unroll
                for (int k2 = 0; k2 < 2; ++k2)
#pragma unroll
                    for (int i = 0; i < 4; ++i) sout[(size_t)(16 * (2 * rto + k2) + 4 * fq + i) * 256] = accS[k2][i];
#undef SC_LOAD
#undef SC_STORE
#undef SC_PUBLISH
            }
            GRID_BAR();
        }
        if (KON(4) && IN(pb + 3)) {
        PHASE_BEGIN();
            for (int m = 2 * gw; m < MT; m += 2 * NGW) {
                v2u raw[8], graw[8]; float ss[8];
#pragma unroll
                for (int q = 0; q < 8; ++q) { const size_t rb = (size_t)(m + (q >> 2)) * ZP + (q & 3) * 256 + 4 * F.lane; raw[q] = *(const GAS v2u*)(Z + rb + CVC); graw[q] = *(const GAS v2u*)(Z + rb + CGC); }
                const f32x4 gg = *(const f32x4*)(ka->in[I_GLAG] + l * 256 + 4 * F.lane);
#pragma unroll
                for (int q = 0; q < 8; ++q) { const float o0 = pg8::bflo(raw[q].x), o1 = pg8::bfhi(raw[q].x), o2 = pg8::bflo(raw[q].y), o3 = pg8::bfhi(raw[q].y); ss[q] = wave_sum((o0 * o0 + o1 * o1) + (o2 * o2 + o3 * o3)); }
#pragma unroll
                for (int q = 0; q < 8; ++q) {
                    const float rstd = 1.0f / sqrtf(ss[q] * (1.f / 256.f) + EPS);
                    v2u w; w.x = pk2(pg8::bflo(raw[q].x) * rstd * gg.x * siluf_(pg8::bflo(graw[q].x)), pg8::bfhi(raw[q].x) * rstd * gg.y * siluf_(pg8::bfhi(graw[q].x)));
                    w.y = pk2(pg8::bflo(raw[q].y) * rstd * gg.z * siluf_(pg8::bflo(graw[q].y)), pg8::bfhi(raw[q].y) * rstd * gg.w * siluf_(pg8::bfhi(graw[q].y)));
                    *(GAS v2u*)(Z + (size_t)(m + (q >> 2)) * ZP + CVC + (q & 3) * 256 + 4 * F.lane) = w;
                }
            }
            GRID_BAR();
        }
        if (KON(5) && IN(pb + 4)) {
        PHASE_BEGIN();
            pg8::Gemm g{XN, W1 + (size_t)N1A * 1024, 1024, 1024, 1024}; pg8::StaticOrder S; S.init(MT / 256, N1B / 256, F.G, (int)blockIdx.x);
            pg8::EpiGm E{Z, ZP};
            for (int rep_ = 0; rep_ < REPS(5); ++rep_) pg8::gemm_phase<pg8::EpiGm, pg8::StaticOrder, true>(F.lds, g, S, E);
            GRID_BAR();
        }
        if (KON(6) && IN(pb + 5)) {
        PHASE_BEGIN();
            pg8::Gemm g{Z + CY, (const bf16*)(ws + WS_WCAT) + (size_t)l * 1024 * 2048, ZP, 2048, 2048}; pg8::StaticOrder S; S.init(MT / 256, 4, F.G, (int)blockIdx.x);
            pg8::EpiMerge E{Z, ZP, XN, 1024};
            for (int rep_ = 0; rep_ < REPS(6); ++rep_) pg8::gemm_phase<pg8::EpiMerge, pg8::StaticOrder, true>(F.lds, g, S, E);
            GRID_BAR();
        }
        if (KON(7) && IN(pb + 6)) {
        PHASE_BEGIN();
            pg8::Gemm g{XN, (const bf16*)(ws + WS_WOUT) + (size_t)l * 1024 * 1024, 1024, 1024, 1024}; pg8::StaticOrder S; S.init(MT / 256, 4, F.G, (int)blockIdx.x);
            pg8::EpiF32 E{OUTF, 1024};
            for (int rep_ = 0; rep_ < REPS(7); ++rep_) pg8::gemm_phase<pg8::EpiF32, pg8::StaticOrder, true>(F.lds, g, S, E);
            GRID_BAR();
        }
        if (KON(8) && IN(pb + 7)) {
        PHASE_BEGIN();
            for (int m = 2 * gw; m < MT; m += 2 * NGW) {
                const float* xprev = (l == 0) ? (m < MP ? ka->in[I_XP] + (size_t)m * DM : ka->in[I_XS] + (size_t)(m - MP) * DM) : dout + (size_t)m * DM;
                const float* modb = mod_l + (size_t)batch_of_row(m) * 3072;
                f32x4 v[2][4], xp[2][4]; float s[2];
#pragma unroll
                for (int r = 0; r < 2; ++r)
#pragma unroll
                    for (int j = 0; j < 4; ++j) { v[r][j] = ((const GAS f32x4*)(OUTF + (size_t)(m + r) * DM) + F.lane)[64 * j]; xp[r][j] = ((const GAS f32x4*)(xprev + (size_t)r * DM) + F.lane)[64 * j]; }
#pragma unroll
                for (int r = 0; r < 2; ++r) { float a = 0.f;
#pragma unroll
                    for (int j = 0; j < 4; ++j) a += (v[r][j].x * v[r][j].x + v[r][j].y * v[r][j].y) + (v[r][j].z * v[r][j].z + v[r][j].w * v[r][j].w);
                    s[r] = a; }
                s[0] = wave_sum(s[0]); s[1] = wave_sum(s[1]);
                float s2[2] = {0.f, 0.f};
#pragma unroll
                for (int j = 0; j < 4; ++j) {
                    const int c = 4 * F.lane + 256 * j;
                    const f32x4 pg = *(const f32x4*)(ka->in[I_POSTG] + l * 1024 + c), gt = *(const f32x4*)(modb + 2048 + c);
#pragma unroll
                    for (int r = 0; r < 2; ++r) {
                        const float rstd = 1.0f / sqrtf(s[r] * (1.f / DM) + EPS);
                        v[r][j] = xp[r][j] + gt * ((v[r][j] * rstd) * pg);
                        *(f32x4*)(dout + (size_t)(m + r) * DM + c) = v[r][j];
                        s2[r] += (v[r][j].x * v[r][j].x + v[r][j].y * v[r][j].y) + (v[r][j].z * v[r][j].z + v[r][j].w * v[r][j].w);
                    }
                }
                if (l + 1 < DEPTH) {
                    s2[0] = wave_sum(s2[0]); s2[1] = wave_sum(s2[1]);
                    const float* modn = mod_all + ((size_t)(l + 1) * 16 + batch_of_row(m)) * 3072;
#pragma unroll
                    for (int j = 0; j < 4; ++j) {
                        const int c = 4 * F.lane + 256 * j;
                        const f32x4 gg = *(const f32x4*)(ka->in[I_PREG] + (l + 1) * 1024 + c), sh = *(const f32x4*)(modn + c), sc = *(const f32x4*)(modn + 1024 + c);
#pragma unroll
                        for (int r = 0; r < 2; ++r) {
                            const float rstd2 = 1.0f / sqrtf(s2[r] * (1.f / DM) + EPS);
                            const f32x4 hh = (v[r][j] * rstd2) * gg * (sc + 1.0f) + sh;
                            ((GAS unsigned long long*)(XN + (size_t)(m + r) * DM) + F.lane)[64 * j] = (unsigned long long)pk2(hh.x, hh.y) | ((unsigned long long)pk2(hh.z, hh.w) << 32);
                        }
                    }
                }
            }
            if (l + 1 < DEPTH) GRID_BAR();
        }
    }
#undef IN
#undef GRID_BAR
#undef mod_all
#undef zlr
#undef wlr_all
#undef XN
#undef Z
#undef OUTF
}

extern "C" void kernel_launch(void* const* d_in, const int* in_sizes, int n_in, void* d_out, int out_size, void* d_ws, size_t ws_size, hipStream_t stream) {
    static int grid = 0;
    if (grid == 0) {
        if (n_in != N_IN || out_size != (int)O_END || ws_size < WS_END) { fprintf(stderr, "kernel_launch: unexpected shapes: n_in %d out %d ws %zu (need %zu)\n", n_in, out_size, ws_size, (size_t)WS_END); grid = -1; return; }
        int dev = 0, cus = 0;
        if (hipGetDevice(&dev) != hipSuccess || hipDeviceGetAttribute(&cus, hipDeviceAttributeMultiprocessorCount, dev) != hipSuccess) { grid = -1; return; }
        if (hipFuncSetAttribute((const void*)mk_fwd, hipFuncAttributeMaxDynamicSharedMemorySize, LDS_BYTES) != hipSuccess) { grid = -1; return; }
        grid = cus;
    }
    if (grid < 0) return;
    (void)hipMemsetAsync((char*)d_ws + WS_CTL, 0, CTL_ZERO_BYTES, stream);
    Args a{};
    for (int i = 0; i < N_IN; ++i) a.in[i] = (const float*)d_in[i];
    a.out = (float*)d_out; a.ws = (unsigned char*)d_ws;
#if MK_N_LAUNCHES == 1
    a.ph_lo = 0; a.ph_hi = NPH; a.li = 0;
    hipLaunchKernelGGL(mk_fwd, dim3(grid), dim3(NWAVES * 64), LDS_BYTES, stream, a);
#else
#ifndef DUP_LO
#define DUP_LO 0
#define DUP_HI 0
#endif
    for (int p = 0; p < NPH; ++p) {
        a.ph_lo = p; a.ph_hi = p + 1; a.li = p; hipLaunchKernelGGL(mk_fwd, dim3(grid), dim3(NWAVES * 64), LDS_BYTES, stream, a);
        if (p + 1 == DUP_HI) for (int q = DUP_LO; q < DUP_HI; ++q) { a.ph_lo = q; a.ph_hi = q + 1; a.li = q; hipLaunchKernelGGL(mk_fwd, dim3(grid), dim3(NWAVES * 64), LDS_BYTES, stream, a); }
    }
#endif
}
```

```cpp
#include <hip/hip_runtime.h>
#include <cstdio>
#include <cstdint>

#ifndef MK_N_LAUNCHES
#define MK_N_LAUNCHES 1
#endif

namespace pg8 {
#define PG8_LAS __attribute__((address_space(3)))
typedef unsigned short bf16_t;
typedef short bf16x8 __attribute__((ext_vector_type(8)));
typedef float f32x4 __attribute__((ext_vector_type(4)));
typedef unsigned u32x4 __attribute__((ext_vector_type(4)));
constexpr int BM = 256, BK = 64, HALF = 128, HTB = HALF * BK * 2, STAGE_BYTES = 8 * HTB, NXCD = 8, WGM = 8;

__host__ __device__ __forceinline__ int lds_byte(int r, int c) { const int st = (r >> 4) * 2 + (c >> 5), rr = r & 15, cc = c & 31, ob = rr * 64 + cc * 2; return st * 1024 + (ob ^ (((ob >> 9) & 1) << 5)); }
__host__ __device__ __forceinline__ void stage_rc(int b, int& R, int& C) { const int st = b / 1024, sb = b % 1024, swz = sb ^ (((sb >> 9) & 1) << 5); R = (st >> 1) * 16 + swz / 64; C = (st & 1) * 32 + (swz % 64) / 2; }
__host__ __device__ __forceinline__ int perm32(int rho) { const int n = rho >> 4, i = rho & 15; return 8 * (i >> 2) + 4 * n + (i & 3); }

struct Unit { int pm, pn; };
struct Gemm { const bf16_t* A; const bf16_t* Bt; int lda, ldb, K; };

struct StaticOrder {
    int nM, nN, nwg, G, c;
    __host__ __device__ void init(int nM_, int nN_, int G_, int c_) { nM = nM_; nN = nN_; nwg = nM * nN; G = G_; c = c_; }
    __host__ __device__ bool next(int i, Unit& u) const { return map((long)i * G + c, u); }
    __host__ __device__ bool map(long L, Unit& u) const {
        if (L >= nwg) return false;
        int wgid = (int)L; { const int q = nwg / NXCD, r = nwg % NXCD, xcd = wgid % NXCD, off = wgid / NXCD; wgid = (xcd < r ? xcd * (q + 1) : r * (q + 1) + (xcd - r) * q) + off; }
        const int nig = WGM * nN, gid = wgid / nig, fm = gid * WGM, gsz = (nM - fm) < WGM ? (nM - fm) : WGM;
        u.pm = fm + ((wgid % nig) % gsz); u.pn = (wgid % nig) / gsz; return true;
    }
};
struct OrderG1a {
    StaticOrder P; int G, c;
    __host__ __device__ void init(int G_, int c_) { P.init(64, 22, G_, c_); G = G_; c = c_; }
    __host__ __device__ bool next(int i, Unit& u) const {
        const long L = (long)i * G + c; if (L < 1408) return P.map(L, u);
        const int j = (int)(L - 1408); if (j >= 68) return false;
        u.pm = 64 + j / 34; u.pn = j % 34; return true;
    }
};

typedef float f32x2_t __attribute__((ext_vector_type(2))); typedef __bf16 bf16x2_t __attribute__((ext_vector_type(2)));
__device__ __forceinline__ unsigned cvt_pk_bf16(float lo, float hi) { f32x2_t v = {lo, hi}; bf16x2_t b = __builtin_convertvector(v, bf16x2_t); return __builtin_bit_cast(unsigned, b); }
__device__ __forceinline__ float bflo(unsigned w) { return __uint_as_float(w << 16); }
__device__ __forceinline__ float bfhi(unsigned w) { return __uint_as_float(w & 0xffff0000u); }
__device__ __forceinline__ float sigmoidf_(float x) { return __builtin_amdgcn_rcpf(1.0f + __builtin_amdgcn_exp2f(-1.4426950408889634f * x)); }

struct EpiZ {
    static constexpr bool PERM = true, AFTER_DRAIN = false, KHOOK = false;
    bf16_t* Z; int ldz; float* pool_p; float* pool_s; bf16_t* GMS;
    __device__ __forceinline__ void operator()(const f32x4 (&acc)[2][2][4][2], const Unit& u, int wr, int wc, int fr, int fq) const {
        const int row0 = u.pm * BM + wr * 64 + fr, col0 = u.pn * BM + wc * 32 + 8 * fq;
        if (u.pn >= 22) {
#pragma unroll
            for (int ai = 0; ai < 2; ++ai)
#pragma unroll
                for (int m = 0; m < 4; ++m) {
                    bf16_t* rowp = GMS + (size_t)(row0 + ai * HALF + m * 16 - 16384) * 3072 + (col0 - 22 * BM);
#pragma unroll
                    for (int bj = 0; bj < 2; ++bj) {
                        const f32x4 v0 = acc[ai][bj][m][0], v1 = acc[ai][bj][m][1];
                        u32x4 w; w.x = cvt_pk_bf16(sigmoidf_(v0[0]), sigmoidf_(v0[1])); w.y = cvt_pk_bf16(sigmoidf_(v0[2]), sigmoidf_(v0[3]));
                        w.z = cvt_pk_bf16(sigmoidf_(v1[0]), sigmoidf_(v1[1])); w.w = cvt_pk_bf16(sigmoidf_(v1[2]), sigmoidf_(v1[3]));
                        *(u32x4*)(rowp + bj * HALF) = w;
                    }
                }
            return;
        }
#pragma unroll
        for (int ai = 0; ai < 2; ++ai)
#pragma unroll
            for (int m = 0; m < 4; ++m) {
                const int r = row0 + ai * HALF + m * 16; bf16_t* rowp = Z + (size_t)r * ldz + col0;
                float* prow = nullptr;
                if (u.pn < 2) {
                    if (r < 16384) { const int t = r & 2047; if (t >= 2033) prow = pool_p + (size_t)((r >> 11) * 15 + (t - 2033)) * 512; }
                    else { const int rs = r - 16384, t = rs & 63; if (t >= 49) prow = pool_s + (size_t)((rs >> 6) * 15 + (t - 49)) * 512; }
                }
#pragma unroll
                for (int bj = 0; bj < 2; ++bj) {
                    const f32x4 v0 = acc[ai][bj][m][0], v1 = acc[ai][bj][m][1];
                    u32x4 w; w.x = cvt_pk_bf16(v0[0], v0[1]); w.y = cvt_pk_bf16(v0[2], v0[3]); w.z = cvt_pk_bf16(v1[0], v1[1]); w.w = cvt_pk_bf16(v1[2], v1[3]);
                    *(u32x4*)(rowp + bj * HALF) = w;
                    if (prow) { *(f32x4*)(prow + col0 + bj * HALF) = v0; *(f32x4*)(prow + col0 + bj * HALF + 4) = v1; }
                }
            }
    }
};
struct EpiGm {
    static constexpr bool PERM = true, AFTER_DRAIN = false, KHOOK = false;
    bf16_t* Z; int ldz;
    __device__ __forceinline__ void operator()(const f32x4 (&acc)[2][2][4][2], const Unit& u, int wr, int wc, int fr, int fq) const {
        const int row0 = u.pm * BM + wr * 64 + fr, col0 = u.pn * BM + wc * 32 + 8 * fq;
#pragma unroll
        for (int ai = 0; ai < 2; ++ai)
#pragma unroll
            for (int m = 0; m < 4; ++m) {
                bf16_t* rowp = Z + (size_t)(row0 + ai * HALF + m * 16) * ldz + col0;
#pragma unroll
                for (int bj = 0; bj < 2; ++bj) {
                    const f32x4 v0 = acc[ai][bj][m][0], v1 = acc[ai][bj][m][1];
                    u32x4 w; w.x = cvt_pk_bf16(sigmoidf_(v0[0]), sigmoidf_(v0[1])); w.y = cvt_pk_bf16(sigmoidf_(v0[2]), sigmoidf_(v0[3]));
                    w.z = cvt_pk_bf16(sigmoidf_(v1[0]), sigmoidf_(v1[1])); w.w = cvt_pk_bf16(sigmoidf_(v1[2]), sigmoidf_(v1[3]));
                    *(u32x4*)(rowp + bj * HALF) = w;
                }
            }
    }
};
struct EpiMerge {
    static constexpr bool PERM = true, AFTER_DRAIN = false, KHOOK = true;
    const bf16_t* G; int ldg; bf16_t* Mo; int ldm;
    __device__ __forceinline__ void khook(f32x4 (&acc)[2][2][4][2], const Unit& u, int t, int wr, int wc, int fr, int fq) const {
        if (t != 8 && t != 16) return;
        const int br = (t == 8) ? 0 : 1;
        asm volatile("" : "+v"(fr), "+v"(fq));
        const int row0 = u.pm * BM + wr * 64 + fr, col0 = u.pn * BM + wc * 32 + 8 * fq;
#pragma unroll
        for (int ai = 0; ai < 2; ++ai)
#pragma unroll
            for (int m = 0; m < 4; ++m) {
                const bf16_t* gp = G + (size_t)(row0 + ai * HALF + m * 16) * ldg + br * 1024 + col0;
#pragma unroll
                for (int bj = 0; bj < 2; ++bj) {
                    const u32x4 nu = *(const u32x4*)(gp + bj * HALF), de = *(const u32x4*)(gp + 1024 + bj * HALF);
                    f32x4 r0, r1;
                    r0[0] = bflo(nu.x) * __builtin_amdgcn_rcpf(bflo(de.x)); r0[1] = bfhi(nu.x) * __builtin_amdgcn_rcpf(bfhi(de.x));
                    r0[2] = bflo(nu.y) * __builtin_amdgcn_rcpf(bflo(de.y)); r0[3] = bfhi(nu.y) * __builtin_amdgcn_rcpf(bfhi(de.y));
                    r1[0] = bflo(nu.z) * __builtin_amdgcn_rcpf(bflo(de.z)); r1[1] = bfhi(nu.z) * __builtin_amdgcn_rcpf(bfhi(de.z));
                    r1[2] = bflo(nu.w) * __builtin_amdgcn_rcpf(bflo(de.w)); r1[3] = bfhi(nu.w) * __builtin_amdgcn_rcpf(bfhi(de.w));
                    acc[ai][bj][m][0] *= r0; acc[ai][bj][m][1] *= r1;
                }
                asm volatile("" ::: "memory");
            }
    }
    __device__ __forceinline__ void operator()(const f32x4 (&acc)[2][2][4][2], const Unit& u, int wr, int wc, int fr, int fq) const {
        const int row0 = u.pm * BM + wr * 64 + fr, col0 = u.pn * BM + wc * 32 + 8 * fq;
#pragma unroll
        for (int ai = 0; ai < 2; ++ai)
#pragma unroll
            for (int m = 0; m < 4; ++m) {
                const int r = row0 + ai * HALF + m * 16;
                const bf16_t* gp = G + (size_t)r * ldg + 2048 + col0; bf16_t* rowp = Mo + (size_t)r * ldm + col0;
#pragma unroll
                for (int bj = 0; bj < 2; ++bj) {
                    const u32x4 g = *(const u32x4*)(gp + bj * HALF);
                    const f32x4 v0 = acc[ai][bj][m][0], v1 = acc[ai][bj][m][1];
                    u32x4 w; w.x = cvt_pk_bf16(v0[0] * bflo(g.x), v0[1] * bfhi(g.x)); w.y = cvt_pk_bf16(v0[2] * bflo(g.y), v0[3] * bfhi(g.y));
                    w.z = cvt_pk_bf16(v1[0] * bflo(g.z), v1[1] * bfhi(g.z)); w.w = cvt_pk_bf16(v1[2] * bflo(g.w), v1[3] * bfhi(g.w));
                    *(u32x4*)(rowp + bj * HALF) = w;
                }
            }
    }
};
struct EpiF32 {
    static constexpr bool PERM = false, AFTER_DRAIN = false, KHOOK = false;
    float* C; int ldc;
    __device__ __forceinline__ void operator()(const f32x4 (&acc)[2][2][4][2], const Unit& u, int wr, int wc, int fr, int fq) const {
        const int row0 = u.pm * BM + wr * 64 + fr, col0 = u.pn * BM + wc * 32 + 4 * fq;
#pragma unroll
        for (int ai = 0; ai < 2; ++ai)
#pragma unroll
            for (int m = 0; m < 4; ++m) { float* rowp = C + (size_t)(row0 + ai * HALF + m * 16) * ldc + col0;
#pragma unroll
                for (int bj = 0; bj < 2; ++bj)
#pragma unroll
                    for (int n = 0; n < 2; ++n) *(f32x4*)(rowp + bj * HALF + n * 16) = acc[ai][bj][m][n]; }
    }
};

template <class Epi, class Sched, bool ALIGN_EPI>
__device__ __forceinline__ void gemm_phase(PG8_LAS unsigned char* lds, const Gemm g, const Sched& S, const Epi& E) {
    int tid_ = threadIdx.x; asm volatile("" : "+v"(tid_));
    const int tid = tid_, wid = __builtin_amdgcn_readfirstlane(tid >> 6), lane = tid & 63, wr = wid >> 2, wc = wid & 3, fr = lane & 15, fq = lane >> 4;
    const int K = g.K, nt = K / BK;
    unsigned voffA[2], voffB[2];
#pragma unroll
    for (int i = 0; i < 2; ++i) { int R, C; stage_rc(tid * 16 + i * 8192, R, C); const int Rb = Epi::PERM ? ((R & ~31) + perm32(R & 31)) : R;
        voffA[i] = (unsigned)(R * g.lda + C) * 2u; voffB[i] = (unsigned)(Rb * g.ldb + C) * 2u; }
    const size_t kstep = (size_t)(BK * 2);
    const size_t hstepA = (size_t)HALF * g.lda * 2, hstepB = (size_t)HALF * g.ldb * 2;
    const size_t tstepA = 2 * hstepA, tstepB = 2 * hstepB;
    const unsigned ldsw = (unsigned)wid * 1024u;
    const int aoff = lds_byte(wr * 64 + fr, fq * 8), boff = lds_byte(wc * 32 + fr, fq * 8);
#define PG8_SA(b, h) (((b) * 2 + (h)) * HTB)
#define PG8_SB(b, h) ((4 + (b) * 2 + (h)) * HTB)
#define PG8_STAGE(bufoff, gbase, voff) do { _Pragma("unroll") for (int _i = 0; _i < 2; ++_i) \
        __builtin_amdgcn_global_load_lds((const unsigned*)((const char*)(gbase) + (voff)[_i]), (PG8_LAS unsigned*)(lds + (bufoff) + ldsw + _i * 8192), 16, 0, 0); } while (0)
#define PG8_LDA(dst, b, h) do { _Pragma("unroll") for (int m = 0; m < 4; ++m) _Pragma("unroll") for (int k = 0; k < 2; ++k) dst[m][k] = *(const PG8_LAS bf16x8*)(lds + PG8_SA(b, h) + aoff + m * 2048 + k * 1024); } while (0)
#define PG8_LDB(dst, b, h) do { _Pragma("unroll") for (int n = 0; n < 2; ++n) _Pragma("unroll") for (int k = 0; k < 2; ++k) dst[n][k] = *(const PG8_LAS bf16x8*)(lds + PG8_SB(b, h) + boff + n * 2048 + k * 1024); } while (0)
#define PG8_MMA(ai, bj, At, Bt) do { __builtin_amdgcn_s_setprio(1); _Pragma("unroll") for (int m = 0; m < 4; ++m) _Pragma("unroll") for (int n = 0; n < 2; ++n) _Pragma("unroll") for (int k = 0; k < 2; ++k) \
        acc[ai][bj][m][n] = __builtin_amdgcn_mfma_f32_16x16x32_bf16(Bt[n][k], At[m][k], acc[ai][bj][m][n], 0, 0, 0); __builtin_amdgcn_s_setprio(0); } while (0)
#define PG8_WAIT_V(n) asm volatile("s_waitcnt vmcnt(" #n ")" ::: "memory")
#define PG8_WAIT_L(n) asm volatile("s_waitcnt lgkmcnt(" #n ")" ::: "memory")
#define PG8_BAR __builtin_amdgcn_s_barrier()
#define PG8_SCHED __builtin_amdgcn_sched_barrier(0)
    Unit cur, nxt; int ui = 0;
    if (!S.next(0, cur)) return;
    f32x4 acc[2][2][4][2];
#pragma unroll
    for (int a = 0; a < 2; ++a)
#pragma unroll
        for (int b = 0; b < 2; ++b)
#pragma unroll
            for (int m = 0; m < 4; ++m)
#pragma unroll
                for (int n = 0; n < 2; ++n) acc[a][b][m][n] = (f32x4){0.f, 0.f, 0.f, 0.f};
    bf16x8 At[4][2], B0[2][2], B1[2][2];
    const char* cA = (const char*)g.A + (size_t)cur.pm * tstepA; const char* cB = (const char*)g.Bt + (size_t)cur.pn * tstepB;
    PG8_STAGE(PG8_SB(0, 0), cB, voffB); PG8_STAGE(PG8_SB(0, 1), cB + hstepB, voffB); PG8_STAGE(PG8_SA(0, 0), cA, voffA); PG8_STAGE(PG8_SA(0, 1), cA + hstepA, voffA);
    if (wr == 1) PG8_BAR;
    PG8_WAIT_V(2); PG8_BAR;
    PG8_STAGE(PG8_SB(1, 0), cB + kstep, voffB); PG8_STAGE(PG8_SA(1, 0), cA + kstep, voffA); PG8_STAGE(PG8_SB(1, 1), cB + hstepB + kstep, voffB);
    PG8_WAIT_V(6); PG8_BAR;
    for (;;) {
        const bool has_next = S.next(ui + 1, nxt);
        const char* nA = has_next ? (const char*)g.A + (size_t)nxt.pm * tstepA : cA; const char* nB = has_next ? (const char*)g.Bt + (size_t)nxt.pn * tstepB : cB;
        for (int t = 0; t < nt; t += 2) {
            const bool last = (t == nt - 2);
            const char* a1 = cA + (size_t)(t + 1) * kstep;
            const char* a2 = last ? nA : cA + (size_t)(t + 2) * kstep; const char* b2 = last ? nB : cB + (size_t)(t + 2) * kstep;
            const char* a3 = a2 + kstep; const char* b3 = b2 + kstep;
            if constexpr (Epi::KHOOK) E.khook(acc, cur, t, wr, wc, fr, fq);
            PG8_LDB(B0, 0, 0); PG8_LDB(B1, 0, 1); PG8_SCHED; PG8_LDA(At, 0, 0); PG8_STAGE(PG8_SA(1, 1), a1 + hstepA, voffA);
            PG8_WAIT_V(8); PG8_WAIT_L(0); PG8_BAR; PG8_MMA(0, 0, At, B0); PG8_MMA(0, 1, At, B1); PG8_BAR; PG8_SCHED;
            PG8_LDA(At, 0, 1); PG8_STAGE(PG8_SB(0, 0), b2, voffB); PG8_STAGE(PG8_SB(0, 1), b2 + hstepB, voffB); PG8_STAGE(PG8_SA(0, 0), a2, voffA);
            PG8_WAIT_V(8); PG8_WAIT_L(0); PG8_BAR; PG8_MMA(1, 0, At, B0); PG8_MMA(1, 1, At, B1); PG8_BAR; PG8_SCHED;
            PG8_LDB(B0, 1, 0); PG8_LDB(B1, 1, 1); PG8_SCHED; PG8_LDA(At, 1, 0); PG8_STAGE(PG8_SA(0, 1), a2 + hstepA, voffA);
            PG8_WAIT_V(8); PG8_WAIT_L(0); PG8_BAR; PG8_MMA(0, 0, At, B0); PG8_MMA(0, 1, At, B1); PG8_BAR; PG8_SCHED;
            PG8_LDA(At, 1, 1); PG8_STAGE(PG8_SB(1, 0), b3, voffB); PG8_STAGE(PG8_SB(1, 1), b3 + hstepB, voffB); PG8_STAGE(PG8_SA(1, 0), a3, voffA);
            PG8_WAIT_V(8); PG8_WAIT_L(0); PG8_BAR; PG8_MMA(1, 0, At, B0); PG8_MMA(1, 1, At, B1); PG8_BAR; PG8_SCHED;
        }
        if constexpr (ALIGN_EPI) { if (wr == 0) PG8_BAR; }
        E(acc, cur, wr, wc, fr, fq);
        if (!has_next) break;
#pragma unroll
        for (int a = 0; a < 2; ++a)
#pragma unroll
            for (int b = 0; b < 2; ++b)
#pragma unroll
                for (int m = 0; m < 4; ++m)
#pragma unroll
                    for (int n = 0; n < 2; ++n) acc[a][b][m][n] = (f32x4){0.f, 0.f, 0.f, 0.f};
        cur = nxt; cA = nA; cB = nB; ++ui;
        if constexpr (ALIGN_EPI) { if (wr == 1) PG8_BAR; }
    }
    PG8_WAIT_V(0);
    if constexpr (!ALIGN_EPI) { if (wr == 0) PG8_BAR; }
    PG8_BAR;
#undef PG8_SA
#undef PG8_SB
#undef PG8_STAGE
#undef PG8_LDA
#undef PG8_LDB
#undef PG8_MMA
#undef PG8_WAIT_V
#undef PG8_WAIT_L
#undef PG8_BAR
#undef PG8_SCHED
}
}

constexpr int NWAVES = 8;
constexpr int DM = 1024, MP = 16384, MS = 512, MT = MP + MS;
constexpr int SEQ = 2048, DSEQ = 64, DEPTH = 2, NB = 8;
constexpr int D_IN = 8720;
constexpr int ZP = 5632;
constexpr int CA = 0, CU = 512, CVB = 1024, CQ = 1536, CK = 2048, CGC = 2560, CGA = 3584, CGB = 4096, CVC = 4608, CY = 3584;
constexpr int N1A = 5632, N1B = 3072, N1 = N1A + N1B;
constexpr float EPS = 1e-6f;
constexpr size_t O_YP = 0, O_YS = 16777216, O_PP = 17301504, O_GP = 17424384, O_PS = 19521536, O_GS = 19644416, O_SV = 21741568, O_END = 22265856;

constexpr size_t MiB = 1u << 20;
constexpr size_t WS_CTL = 0, CTL_ZERO_BYTES = 64 * 1024;
constexpr size_t WS_MOD = 1 * MiB;
constexpr size_t WS_SGUW = 1 * MiB + 512 * 1024;
constexpr size_t WS_PWT = 1 * MiB + 768 * 1024;
constexpr size_t WS_ZLR = 2 * MiB;
constexpr size_t WS_WLR = 3 * MiB + 512 * 1024;
constexpr size_t WS_WLRB = 3 * MiB + 640 * 1024;
constexpr size_t WS_W1 = 4 * MiB;
constexpr size_t WS_WCAT = 38 * MiB;
constexpr size_t WS_WOUT = 46 * MiB;
constexpr size_t WS_XN = 50 * MiB;
constexpr size_t WS_Z = 83 * MiB;
constexpr size_t WS_ABUF = WS_Z + (size_t)MT * ZP * 2;
constexpr size_t WS_DEC = WS_ABUF + (size_t)1056 * 5120;
constexpr size_t WS_GMS = 271 * MiB;
constexpr size_t WS_OUTS = 274 * MiB;
constexpr size_t WS_MB = 276 * MiB;
constexpr size_t WS_END = WS_MB + (size_t)MT * 1024 * 2;
static_assert(WS_DEC + (size_t)1056 * 512 <= WS_GMS && WS_GMS + (size_t)512 * 3072 * 2 <= WS_OUTS && WS_OUTS + (size_t)512 * 1024 * 4 <= WS_MB, "ws map 2");
static_assert(WS_ZLR + (size_t)MT * 16 * 4 <= WS_WLR && WS_W1 + (size_t)2 * N1 * 1024 * 2 <= WS_WCAT && WS_WCAT + (size_t)2 * 1024 * 2048 * 2 <= WS_WOUT && WS_WOUT + (size_t)2 * 1024 * 1024 * 2 <= WS_XN && WS_XN + (size_t)MT * 1024 * 2 <= WS_Z, "ws map");
constexpr int CW_TMO = 0, CW_BAR = 4096, CW_SPAN = 8192;

constexpr int RING_BYTES = 131072, LDSCTL_OFF = RING_BYTES, MISC_OFF = LDSCTL_OFF + 320, LDS_BYTES = 147456;

#define GAS __attribute__((address_space(1)))
#define LAS __attribute__((address_space(3)))
typedef unsigned short bf16;
typedef unsigned v4u __attribute__((ext_vector_type(4)));
typedef unsigned v2u __attribute__((ext_vector_type(2)));
typedef float f32x4 __attribute__((ext_vector_type(4)));
typedef GAS unsigned gu32;
#define RLX_AGENT __ATOMIC_RELAXED, __HIP_MEMORY_SCOPE_AGENT
#define LDS_WAIT() asm volatile("s_waitcnt lgkmcnt(0)" ::: "memory")
__device__ __forceinline__ unsigned f2bf(float f) { unsigned u = __builtin_bit_cast(unsigned, f); return (u + 0x7fffu + ((u >> 16) & 1u)) >> 16; }
__device__ __forceinline__ unsigned pk2(float lo, float hi) { return f2bf(lo) | (f2bf(hi) << 16); }
__device__ __forceinline__ float bf2f(bf16 v) { return __uint_as_float((unsigned)v << 16); }
__device__ __forceinline__ float siluf_(float x) { return x * __builtin_amdgcn_rcpf(1.0f + __expf(-x)); }

#define XB_TMO      128
#define XB_XCNT(j)  (256  + 64 * (j))
#define XB_XSUB(j)  (1280 + 64 * (j))
#define XB_XGEN(j)  (2304 + 64 * (j))
#define XB_TOP      3328
#define XB_TOPGEN   3392
#define XCD_BAR_WORDS 3456
#define XB_SPIN_CAP (1u << 18)
__device__ __forceinline__ unsigned xb_ld(unsigned* p)              { return __hip_atomic_load(p, __ATOMIC_RELAXED, __HIP_MEMORY_SCOPE_AGENT); }
__device__ __forceinline__ unsigned xb_add(unsigned* p, unsigned v) { return __hip_atomic_fetch_add(p, v, __ATOMIC_RELAXED, __HIP_MEMORY_SCOPE_AGENT); }
__device__ __forceinline__ unsigned xb_xcc_id() { return (unsigned)__builtin_amdgcn_s_getreg((3 << 11) | 20) & 0xFu; }
#define XB_SPIN(cond, bar) do { unsigned _sp = 0; while (cond) { __builtin_amdgcn_s_sleep(1); \
    if ((++_sp & 255u) == 0u) { if (xb_ld(&(bar)[XB_TMO])) break; if (_sp > XB_SPIN_CAP) { atomicAdd(&(bar)[XB_TMO], 1u); break; } } } } while (0)
struct XcdBarrier { unsigned* bar; unsigned x; volatile LAS unsigned* st; };
__device__ __forceinline__ XcdBarrier xcd_barrier_post(unsigned* bar, volatile LAS unsigned* st) {
    XcdBarrier b; b.bar = bar; b.x = xb_xcc_id(); b.st = st;
    if (threadIdx.x == 0) (void)xb_add(&bar[XB_XCNT(b.x)], 1u);
    return b;
}
__device__ __forceinline__ void xcd_barrier_complete(unsigned* bar, unsigned x, unsigned& nloc, unsigned& nx) {
    const unsigned G = gridDim.x * gridDim.y * gridDim.z;
    unsigned sum, cnt, mine, sp = 0u;
    for (;;) {
        sum = 0u; cnt = 0u; mine = 0u;
#pragma unroll
        for (unsigned j = 0; j < 16; ++j) { const unsigned c = xb_ld(&bar[XB_XCNT(j)]); sum += c; cnt += (c > 0u) ? 1u : 0u; mine = (j == x) ? c : mine; }
        if (sum == G) break;
        __builtin_amdgcn_s_sleep(1);
        if ((++sp & 255u) == 0u) { if (xb_ld(&bar[XB_TMO])) break; if (sp > XB_SPIN_CAP) { atomicAdd(&bar[XB_TMO], 1u); break; } }
    }
    nloc = mine > 0u ? mine : 1u; nx = cnt > 0u ? cnt : 1u;
}
__device__ __forceinline__ void xcd_barrier(const XcdBarrier& b) {
    asm volatile("s_waitcnt vmcnt(0)" ::: "memory");
    __syncthreads();
    if (threadIdx.x == 0) {
        unsigned* bar = b.bar;
        __builtin_amdgcn_s_waitcnt(0);
        unsigned nloc = b.st[0], nx = b.st[1];
        if (nloc == 0u) { xcd_barrier_complete(bar, b.x, nloc, nx); b.st[0] = nloc; b.st[1] = nx; }
        const unsigned old = xb_add(&bar[XB_XSUB(b.x)], 1u);
        const unsigned gen = old / nloc;
        if (old + 1u == (gen + 1u) * nloc) {
            __builtin_amdgcn_fence(__ATOMIC_RELEASE, "agent");
            asm volatile("s_waitcnt vmcnt(0)" ::: "memory");
            const unsigned og = xb_add(&bar[XB_TOP], 1u);
            const unsigned tg = og / nx;
            if (og + 1u == (tg + 1u) * nx) xb_add(&bar[XB_TOPGEN], 1u);
            else XB_SPIN(xb_ld(&bar[XB_TOPGEN]) == tg, bar);
            __builtin_amdgcn_fence(__ATOMIC_ACQUIRE, "agent");
            xb_add(&bar[XB_XGEN(b.x)], 1u);
            asm volatile("s_waitcnt vmcnt(0)" ::: "memory");
        } else {
            XB_SPIN(xb_ld(&bar[XB_XGEN(b.x)]) == gen, bar);
            __builtin_amdgcn_fence(__ATOMIC_ACQUIRE, "agent");
            asm volatile("s_waitcnt vmcnt(0)" ::: "memory");
        }
    }
    __syncthreads();
}

__device__ __forceinline__ int opq(int x) { asm volatile("" : "+v"(x)); return x; }
struct Frame {
    LAS unsigned char* lds;
    int tid, lane, wave, vcu, G;
};
__device__ __forceinline__ float wave_sum(float v) {
    v += __int_as_float(__builtin_amdgcn_ds_swizzle(__float_as_int(v), 0x041F));
    v += __int_as_float(__builtin_amdgcn_ds_swizzle(__float_as_int(v), 0x081F));
    v += __int_as_float(__builtin_amdgcn_ds_swizzle(__float_as_int(v), 0x101F));
    v += __int_as_float(__builtin_amdgcn_ds_swizzle(__float_as_int(v), 0x201F));
    v += __int_as_float(__builtin_amdgcn_ds_swizzle(__float_as_int(v), 0x401F));
    const auto rr = __builtin_amdgcn_permlane32_swap(__float_as_uint(v), __float_as_uint(v), false, false);
    return __uint_as_float(rr[0]) + __uint_as_float(rr[1]);
}
enum { I_XP = 0, I_XS, I_SPOOL, I_SGLA, I_CP, I_CS, I_ADAW, I_ADAB, I_PREG, I_POSTG, I_WIN, I_POOLW, I_POOLS, I_SGUG, I_SGUW, I_SGUB, I_WA2, I_BA, I_GLAG, I_WOA, I_WOB, I_WOC, I_WOUT, N_IN };
struct Args { const float* in[N_IN]; float* out; unsigned char* ws; int ph_lo, ph_hi, li, pad; };

__device__ __forceinline__ void transpose_item(const float* src, int ldsrc, bf16* dst, int ldd, LAS float* scr, int lane) {
    f32x4 v[8];
    const int kr = lane >> 3, nq = lane & 7;
#pragma unroll
    for (int i = 0; i < 8; ++i) v[i] = *(const GAS f32x4*)(src + (size_t)(8 * i + kr) * ldsrc + 4 * nq);
#pragma unroll
    for (int i = 0; i < 8; ++i) { LAS float* p = scr + (8 * i + kr) * 33 + 4 * nq; p[0] = v[i].x; p[1] = v[i].y; p[2] = v[i].z; p[3] = v[i].w; }
    LDS_WAIT(); asm volatile("" ::: "memory");
    const int c = lane & 7;
#pragma unroll
    for (int j = 0; j < 4; ++j) { const int n = (lane >> 3) + 8 * j; const LAS float* s = scr + (8 * c) * 33 + n;
        v4u o; o.x = pk2(s[0 * 33], s[1 * 33]); o.y = pk2(s[2 * 33], s[3 * 33]); o.z = pk2(s[4 * 33], s[5 * 33]); o.w = pk2(s[6 * 33], s[7 * 33]);
        *(GAS v4u*)(dst + (size_t)n * ldd + 8 * c) = o; }
    LDS_WAIT(); asm volatile("" ::: "memory");
}
__device__ __forceinline__ int w1_src_col(int n) {
    if (n < 512) return n;
    if (n < 1024) return 1024 + (n - 512);
    if (n < 1536) return 1536 + (n - 1024);
    if (n < 2048) return 2560 + (n - 1536);
    if (n < 2560) return 3072 + (n - 2048);
    if (n < 3584) return 4608 + (n - 2560);
    if (n < 4096) return 512 + (n - 3584);
    if (n < 4608) return 2048 + (n - 4096);
    if (n < 5632) return 3584 + (n - 4608);
    return 5648 + (n - 5632);
}
__device__ __forceinline__ int batch_of_row(int m) { return m < MP ? (m >> 11) : 8 + ((m - MP) >> 6); }

__device__ __forceinline__ void xn_rows2(const float* xrow0, const float* g, const float* mod  , bf16* orow0, int lane) {
    f32x4 v[2][4]; float s[2];
#pragma unroll
    for (int r = 0; r < 2; ++r)
#pragma unroll
        for (int j = 0; j < 4; ++j) v[r][j] = ((const GAS f32x4*)(xrow0 + (size_t)r * DM) + lane)[64 * j];
#pragma unroll
    for (int r = 0; r < 2; ++r) { float a = 0.f;
#pragma unroll
        for (int j = 0; j < 4; ++j) a += (v[r][j].x * v[r][j].x + v[r][j].y * v[r][j].y) + (v[r][j].z * v[r][j].z + v[r][j].w * v[r][j].w);
        s[r] = a; }
    s[0] = wave_sum(s[0]); s[1] = wave_sum(s[1]);
#pragma unroll
    for (int j = 0; j < 4; ++j) {
        const int c = 4 * lane + 256 * j;
        const f32x4 gg = *(const f32x4*)(g + c), sh = *(const f32x4*)(mod + c), sc = *(const f32x4*)(mod + 1024 + c);
#pragma unroll
        for (int r = 0; r < 2; ++r) {
            const float rstd = 1.0f / sqrtf(s[r] * (1.f / DM) + EPS);
            const f32x4 h = (v[r][j] * rstd) * gg * (sc + 1.0f) + sh;
            ((GAS unsigned long long*)(orow0 + (size_t)r * DM) + lane)[64 * j] = (unsigned long long)pk2(h.x, h.y) | ((unsigned long long)pk2(h.z, h.w) << 32);
        }
    }
}


typedef float f32x16 __attribute__((ext_vector_type(16)));
template <int KLEN> __device__ __forceinline__ f32x16 piece_mma(const bf16* aptr, const bf16* bptr) {
    f32x16 acc;
#pragma unroll
    for (int i = 0; i < 16; ++i) acc[i] = 0.f;
#pragma unroll 1
    for (int blk = 0; blk < KLEN / 128; ++blk) {
        pg8::bf16x8 a[8], b[8];
#pragma unroll
        for (int i = 0; i < 8; ++i) { a[i] = *(const GAS pg8::bf16x8*)(aptr + 128 * blk + 8 * i); b[i] = *(const GAS pg8::bf16x8*)(bptr + 128 * blk + 8 * i); }
#pragma unroll
        for (int i = 0; i < 8; ++i) acc = __builtin_amdgcn_mfma_f32_32x32x16_bf16(b[i], a[i], acc, 0, 0, 0);
    }
    return acc;
}
__device__ __forceinline__ void rowpost2(const float* orow0, const float* xprev0, const float* modb, const float* postg, float* xout0, bool has_next, const float* modn, const float* pregn, bf16* xn0, int lane) {
    f32x4 v[2][4], xp[2][4]; float s[2];
#pragma unroll
    for (int r = 0; r < 2; ++r)
#pragma unroll
        for (int j = 0; j < 4; ++j) { v[r][j] = ((const GAS f32x4*)(orow0 + (size_t)r * DM) + lane)[64 * j]; xp[r][j] = ((const GAS f32x4*)(xprev0 + (size_t)r * DM) + lane)[64 * j]; }
#pragma unroll
    for (int r = 0; r < 2; ++r) { float a = 0.f;
#pragma unroll
        for (int j = 0; j < 4; ++j) a += (v[r][j].x * v[r][j].x + v[r][j].y * v[r][j].y) + (v[r][j].z * v[r][j].z + v[r][j].w * v[r][j].w);
        s[r] = a; }
    s[0] = wave_sum(s[0]); s[1] = wave_sum(s[1]);
    float s2[2] = {0.f, 0.f};
#pragma unroll
    for (int j = 0; j < 4; ++j) {
        const int c = 4 * lane + 256 * j;
        const f32x4 pg = *(const f32x4*)(postg + c), gt = *(const f32x4*)(modb + 2048 + c);
#pragma unroll
        for (int r = 0; r < 2; ++r) {
            const float rstd = 1.0f / sqrtf(s[r] * (1.f / DM) + EPS);
            v[r][j] = xp[r][j] + gt * ((v[r][j] * rstd) * pg);
            *(f32x4*)(xout0 + (size_t)r * DM + c) = v[r][j];
            s2[r] += (v[r][j].x * v[r][j].x + v[r][j].y * v[r][j].y) + (v[r][j].z * v[r][j].z + v[r][j].w * v[r][j].w);
        }
    }
    if (has_next) {
        s2[0] = wave_sum(s2[0]); s2[1] = wave_sum(s2[1]);
#pragma unroll
        for (int j = 0; j < 4; ++j) {
            const int c = 4 * lane + 256 * j;
            const f32x4 gg = *(const f32x4*)(pregn + c), sh = *(const f32x4*)(modn + c), sc = *(const f32x4*)(modn + 1024 + c);
#pragma unroll
            for (int r = 0; r < 2; ++r) {
                const float rstd2 = 1.0f / sqrtf(s2[r] * (1.f / DM) + EPS);
                const f32x4 hh = (v[r][j] * rstd2) * gg * (sc + 1.0f) + sh;
                ((GAS unsigned long long*)(xn0 + (size_t)r * DM) + lane)[64 * j] = (unsigned long long)pk2(hh.x, hh.y) | ((unsigned long long)pk2(hh.z, hh.w) << 32);
            }
        }
    }
}

constexpr int NPH = 18;

__global__ void __launch_bounds__(NWAVES * 64, 2) mk_fwd(Args args) {
    extern __shared__ __attribute__((aligned(16))) unsigned char lds[];
    Frame F;
    F.lds = (LAS unsigned char*)lds;
    volatile LAS unsigned* MISC = (volatile LAS unsigned*)(F.lds + MISC_OFF);
    F.tid = threadIdx.x; F.lane = F.tid & 63; F.wave = __builtin_amdgcn_readfirstlane(F.tid >> 6);
    F.G = gridDim.x; { const int bx = blockIdx.x; F.vcu = (F.G % 8 == 0) ? (bx % 8) * (F.G / 8) + bx / 8 : bx; }
    typedef const Args __attribute__((address_space(4)))* KArgs;
    KArgs ka = (KArgs)__builtin_amdgcn_kernarg_segment_ptr();
    unsigned char* ws = args.ws;
    gu32* ctl = (gu32*)(ws + WS_CTL);
    for (int u = F.tid; u < (LDS_BYTES - LDSCTL_OFF) / 4; u += NWAVES * 64) ((LAS unsigned*)(F.lds + LDSCTL_OFF))[u] = 0u;
    __syncthreads();
    XcdBarrier bar; bar.bar = (unsigned*)(ctl + CW_BAR); bar.x = 0; bar.st = nullptr;
    if (MK_N_LAUNCHES == 1) bar = xcd_barrier_post((unsigned*)(ctl + CW_BAR), MISC + 8);
#define GRID_BAR() do { if (MK_N_LAUNCHES == 1) { xcd_barrier(bar); if (REPS(15) == 2) xcd_barrier(bar); } } while (0)
    const int lo = args.ph_lo, hi = args.ph_hi;
#ifndef ABLMASK
#define ABLMASK 0xffff
#endif
#define IN(k) (lo <= (k) && (k) < hi)
#define PHASE_BEGIN() do { F.tid = opq((int)threadIdx.x); F.lane = F.tid & 63; unsigned long long kp_ = (unsigned long long)__builtin_amdgcn_kernarg_segment_ptr(); asm volatile("" : "+s"(kp_)); \
        ka = (KArgs)kp_; ws = ka->ws; dout = ka->out; } while (0)
#define KON(b) ((ABLMASK >> (b)) & 1)
#ifndef DUPMASK
#define DUPMASK 0
#endif
#define REPS(b) (((DUPMASK >> (b)) & 1) ? 2 : 1)
#define mod_all ((float*)(ws + WS_MOD))
#define zlr ((float*)(ws + WS_ZLR))
#define wlr_all ((float*)(ws + WS_WLR))
#define XN ((bf16*)(ws + WS_XN))
#define Z ((bf16*)(ws + WS_Z))
#define OUTF ((float*)(ws + WS_Z))
    float* dout = args.out;
    const int gw = F.vcu * NWAVES + F.wave, NGW = F.G * NWAVES;

    if (KON(0) && IN(0)) for (int rep_ = 0; rep_ < REPS(0); ++rep_) {
        PHASE_BEGIN();
        LAS float* scr = (LAS float*)(F.lds + F.wave * 16384);
        constexpr int I_W1 = (1024 / 64) * (N1 / 32);
        constexpr int I_OA = (512 / 64) * 32, I_OC = (1024 / 64) * 32, I_OUT = (1024 / 64) * 32;
        constexpr int PER_L = I_W1 + 2 * I_OA + I_OC + I_OUT;
        for (int it = gw; it < 2 * PER_L; it += NGW) {
            const int l = it / PER_L; int r = it % PER_L;
            if (r < I_W1) { const int nb = r % (N1 / 32), kb = r / (N1 / 32); const int n0 = 32 * nb, k0 = 64 * kb;
                transpose_item(ka->in[I_WIN] + (size_t)l * 1024 * D_IN + (size_t)k0 * D_IN + w1_src_col(n0), D_IN, (bf16*)(ws + WS_W1) + ((size_t)l * N1 + n0) * 1024 + k0, 1024, scr, F.lane); continue; }
            r -= I_W1;
            bf16* wcat = (bf16*)(ws + WS_WCAT) + (size_t)l * 1024 * 2048;
            if (r < I_OA) { const int nb = r % 32, kb = r / 32; transpose_item(ka->in[I_WOA] + (size_t)l * 512 * 1024 + (size_t)(64 * kb) * 1024 + 32 * nb, 1024, wcat + (size_t)(32 * nb) * 2048 + 64 * kb, 2048, scr, F.lane); continue; }
            r -= I_OA;
            if (r < I_OA) { const int nb = r % 32, kb = r / 32; transpose_item(ka->in[I_WOB] + (size_t)l * 512 * 1024 + (size_t)(64 * kb) * 1024 + 32 * nb, 1024, wcat + (size_t)(32 * nb) * 2048 + 512 + 64 * kb, 2048, scr, F.lane); continue; }
            r -= I_OA;
            if (r < I_OC) { const int nb = r % 32, kb = r / 32; transpose_item(ka->in[I_WOC] + (size_t)l * 1024 * 1024 + (size_t)(64 * kb) * 1024 + 32 * nb, 1024, wcat + (size_t)(32 * nb) * 2048 + 1024 + 64 * kb, 2048, scr, F.lane); continue; }
            r -= I_OC;
            { const int nb = r % 32, kb = r / 32; transpose_item(ka->in[I_WOUT] + (size_t)l * 1024 * 1024 + (size_t)(64 * kb) * 1024 + 32 * nb, 1024, (bf16*)(ws + WS_WOUT) + (size_t)l * 1024 * 1024 + (size_t)(32 * nb) * 1024 + 64 * kb, 1024, scr, F.lane); }
        }
        for (int i = blockIdx.x * 512 + F.tid; i < 2 * 4 * 128 * 128; i += F.G * 512) {
            const int jj = i & 127, ii = (i >> 7) & 127, lg = i >> 14;
            ((bf16*)(ws + WS_SGUW))[i] = (bf16)f2bf(jj <= ii ? ka->in[I_SGUW][i] : 0.f);
            ((bf16*)(ws + WS_PWT))[i] = (bf16)f2bf(ka->in[I_POOLW][(size_t)lg * 16384 + jj * 128 + ii]);
        }
        for (int i = blockIdx.x * 512 + F.tid; i < 2 * 16 * 1024; i += F.G * 512) { const int l = i >> 14, r = (i >> 10) & 15, k = i & 1023; ((bf16*)(ws + WS_WLRB))[i] = (bf16)f2bf(ka->in[I_WIN][(size_t)l * 1024 * D_IN + (size_t)k * D_IN + 5632 + r]); }
        for (int i = blockIdx.x * 512 + F.tid; i < 2 * 16 * 1024; i += F.G * 512) { const int l = i >> 14, r = (i >> 10) & 15, k = i & 1023; wlr_all[i] = ka->in[I_WIN][(size_t)l * 1024 * D_IN + (size_t)k * D_IN + 5632 + r]; }
        __syncthreads();
        LAS float* sc = (LAS float*)F.lds;
        LAS float* part = (LAS float*)(F.lds + 65536);
        for (int i = F.tid; i < 16 * 1024; i += 512) { const int bi = i >> 10, k = i & 1023; const float cv = bi < 8 ? ka->in[I_CP][bi * 1024 + k] : ka->in[I_CS][(bi - 8) * 1024 + k]; sc[i] = siluf_(cv); }
        __syncthreads();
        for (int it = (F.vcu + 64) % F.G; it < 2 * 96; it += F.G) {
            const int l = it / 96, j0 = (it % 96) * 32, col = F.tid & 31, ks = F.tid >> 5;
            float a[16];
#pragma unroll
            for (int b = 0; b < 16; ++b) a[b] = 0.f;
            const float* wp = ka->in[I_ADAW] + (size_t)l * 1024 * 3072 + j0 + col;
#pragma unroll 16
            for (int k = ks * 64; k < ks * 64 + 64; ++k) {
                const float w = wp[(size_t)k * 3072];
#pragma unroll
                for (int b = 0; b < 16; ++b) a[b] += sc[b * 1024 + k] * w;
            }
#pragma unroll
            for (int b = 0; b < 16; ++b) part[(ks * 16 + b) * 32 + col] = a[b];
            __syncthreads();
            { const int b = F.tid >> 5, j = F.tid & 31; float s = 0.f;
#pragma unroll
                for (int w = 0; w < 16; ++w) s += part[(w * 16 + b) * 32 + j];
                mod_all[((size_t)l * 16 + b) * 3072 + j0 + j] = s + ka->in[I_ADAB][l * 3072 + j0 + j]; }
            __syncthreads();
        }
        GRID_BAR();
    }
    if (KON(1) && IN(1)) for (int rep_ = 0; rep_ < REPS(1); ++rep_) {
        PHASE_BEGIN();
        for (int m = 2 * gw; m < MT; m += 2 * NGW) {
            const float* xrow = m < MP ? ka->in[I_XP] + (size_t)m * DM : ka->in[I_XS] + (size_t)(m - MP) * DM;
            xn_rows2(xrow, ka->in[I_PREG], mod_all + (size_t)batch_of_row(m) * 3072, XN + (size_t)m * DM, F.lane);
        }
        GRID_BAR();
    }
    for (int l = 0; l < DEPTH; ++l) {
        const int pb = 2 + 8 * l;
        const float* mod_l = mod_all + (size_t)l * 16 * 3072;
        const bf16* W1 = (const bf16*)(ws + WS_W1) + (size_t)l * N1 * 1024;
        if (KON(2) && IN(pb + 0)) {
        PHASE_BEGIN();
            {
                const bf16* wl = (const bf16*)(ws + WS_WLRB) + (size_t)l * 16 * 1024;
                const int fr = F.lane & 15, fq = F.lane >> 4;
                for (int tile = gw; tile < MT / 16; tile += NGW) {
                    const bf16* ap = XN + (size_t)(16 * tile + fr) * DM + 8 * fq; const bf16* bp = wl + (size_t)fr * 1024 + 8 * fq;
                    pg8::f32x4 acc = {0.f, 0.f, 0.f, 0.f};
#pragma unroll 8
                    for (int s = 0; s < 32; ++s) {
                        const pg8::bf16x8 af = *(const GAS pg8::bf16x8*)(ap + 32 * s), bf = *(const GAS pg8::bf16x8*)(bp + 32 * s);
                        acc = __builtin_amdgcn_mfma_f32_16x16x32_bf16(af, bf, acc, 0, 0, 0);
                    }
#pragma unroll
                    for (int e = 0; e < 4; ++e) zlr[(size_t)(16 * tile + 4 * fq + e) * 16 + fr] = acc[e];
                }
            }
            __syncthreads();
            pg8::Gemm g{XN, W1, 1024, 1024, 1024}; pg8::OrderG1a S; S.init(F.G, (int)blockIdx.x);
            pg8::EpiZ E{Z, ZP, dout + O_PP + (size_t)l * NB * 15 * 512, dout + O_PS + (size_t)l * NB * 15 * 512, (bf16*)(ws + WS_GMS)};
            pg8::gemm_phase<pg8::EpiZ, pg8::OrderG1a, true>(F.lds, g, S, E);
            GRID_BAR();
        }
        if (KON(3) && IN(pb + 1)) {
        PHASE_BEGIN();
            {
                LAS float* at = (LAS float*)F.lds;
                LAS unsigned char* DT = F.lds + 79 * 128 * 4;
                const int fr = F.lane & 15, fq = F.lane >> 4;
                for (int it = F.vcu; it < (MT / 64) * 4; it += F.G) {
                    const int tile = it >> 2, g = it & 3, w = 2 << g;
                    const int m0 = tile * 64; const bool smp = m0 >= MP;
                    const int bb = smp ? ((m0 - MP) >> 6) : (m0 >> 11), t0 = smp ? 0 : (m0 & 2047), pos0 = smp ? SEQ : 0;
                    for (int i = F.tid; i < 79 * 16; i += 512) {
                        const int ri = i >> 4, p = i & 15, t = t0 - 15 + ri; f32x4 v0 = {0.f, 0.f, 0.f, 0.f}, v1 = v0;
                        if (t >= 0) { const v4u raw = *(const GAS v4u*)(Z + (size_t)(m0 - 15 + ri) * ZP + CA + g * 128 + 8 * p);
                            v0 = (f32x4){pg8::bflo(raw.x), pg8::bfhi(raw.x), pg8::bflo(raw.y), pg8::bfhi(raw.y)}; v1 = (f32x4){pg8::bflo(raw.z), pg8::bfhi(raw.z), pg8::bflo(raw.w), pg8::bfhi(raw.w)}; }
                        else if (smp) { const float* sp = ka->in[I_SPOOL] + (((size_t)l * NB + bb) * 15 + (15 + t)) * 512 + g * 128 + 8 * p; v0 = *(const f32x4*)sp; v1 = *(const f32x4*)(sp + 4); }
                        *(LAS f32x4*)(at + ri * 128 + 8 * p) = v0; *(LAS f32x4*)(at + ri * 128 + 8 * p + 4) = v1;
                    }
                    __syncthreads();
                    {
                        const int tt = F.tid >> 3, c0 = 16 * (F.tid & 7);
                        const int pos = pos0 + t0 + tt; const float rc = 1.0f / (float)((pos + 1) < w ? (pos + 1) : w);
                        f32x4 s[4];
#pragma unroll
                        for (int q = 0; q < 4; ++q) s[q] = (f32x4){0.f, 0.f, 0.f, 0.f};
                        for (int k = 0; k < w; ++k) {
#pragma unroll
                            for (int q = 0; q < 4; ++q) s[q] += *(const LAS f32x4*)(at + (tt + 15 - k) * 128 + c0 + 4 * q);
                        }
                        unsigned pk[8];
#pragma unroll
                        for (int q = 0; q < 4; ++q) { const f32x4 a0 = *(const LAS f32x4*)(at + (tt + 15) * 128 + c0 + 4 * q); const f32x4 dd = s[q] * rc - a0; pk[2 * q] = pk2(dd.x, dd.y); pk[2 * q + 1] = pk2(dd.z, dd.w); }
                        *(LAS v4u*)(DT + tt * 272 + c0 * 2) = (v4u){pk[0], pk[1], pk[2], pk[3]}; *(LAS v4u*)(DT + tt * 272 + c0 * 2 + 16) = (v4u){pk[4], pk[5], pk[6], pk[7]};
                    }
                    __syncthreads();
                    {
                        const int ctw = F.wave;
                        const bf16* pwt = (const bf16*)(ws + WS_PWT) + ((size_t)(l * 4 + g) * 128 + 16 * ctw + fr) * 128 + 8 * fq;
                        pg8::bf16x8 pwf[4];
#pragma unroll
                        for (int s2 = 0; s2 < 4; ++s2) pwf[s2] = *(const GAS pg8::bf16x8*)(pwt + 32 * s2);
                        const f32x4 ps = *(const f32x4*)(ka->in[I_POOLS] + l * 512 + g * 128 + 16 * ctw + 4 * fq);
                        v2u graw[4];
#pragma unroll
                        for (int rt = 0; rt < 4; ++rt) graw[rt] = *(const GAS v2u*)(Z + (size_t)(m0 + 16 * rt + fr) * ZP + CGA + g * 128 + 16 * ctw + 4 * fq);
#pragma unroll
                        for (int rt = 0; rt < 4; ++rt) {
                            pg8::f32x4 acc = {0.f, 0.f, 0.f, 0.f};
#pragma unroll
                            for (int s2 = 0; s2 < 4; ++s2) { const pg8::bf16x8 df = *(const LAS pg8::bf16x8*)(DT + (16 * rt + fr) * 272 + (32 * s2 + 8 * fq) * 2); acc = __builtin_amdgcn_mfma_f32_16x16x32_bf16(pwf[s2], df, acc, 0, 0, 0); }
                            bf16* p = Z + (size_t)(m0 + 16 * rt + fr) * ZP + CGA + g * 128 + 16 * ctw + 4 * fq;
                            v2u o; o.x = pk2(acc[0] * ps.x * siluf_(pg8::bflo(graw[rt].x)), acc[1] * ps.y * siluf_(pg8::bfhi(graw[rt].x))); o.y = pk2(acc[2] * ps.z * siluf_(pg8::bflo(graw[rt].y)), acc[3] * ps.w * siluf_(pg8::bfhi(graw[rt].y)));
                            *(GAS v2u*)p = o;
                        }
                    }
                    __syncthreads();
                }
            }
            {
                LAS unsigned char* VN = F.lds;
                LAS unsigned char* WT = F.lds + 128 * 272;
                const int fr = F.lane & 15, fq = F.lane >> 4;
                for (int it = (F.vcu + 224) % F.G; it < 136 * 4; it += F.G) {
                    const int ch = it >> 2, g = it & 3;
                    const bool smp = ch >= 128; const int L = smp ? 64 : 128, m0 = smp ? MP + (ch - 128) * 64 : ch * 128;
                    for (int i = F.tid; i < 2048; i += 512) { const int row = i >> 4, p = i & 15;
                        *(LAS v4u*)(WT + row * 272 + p * 16) = *(const GAS v4u*)((const bf16*)(ws + WS_SGUW) + ((size_t)(l * 4 + g) * 128 + row) * 128 + 8 * p); }
                    {
                        const int c0 = 8 * (F.lane & 15);
                        const f32x4 g0 = *(const f32x4*)(ka->in[I_SGUG] + l * 512 + g * 128 + c0), g1 = *(const f32x4*)(ka->in[I_SGUG] + l * 512 + g * 128 + c0 + 4);
                        for (int r0 = 0; 8 * r0 < L; r0 += 4) {
                            v4u rawv[4];
#pragma unroll
                            for (int r = 0; r < 4; ++r) rawv[r] = *(const GAS v4u*)(Z + (size_t)(m0 + F.wave + 8 * (r0 + r)) * ZP + CVB + 8 * F.lane);
#pragma unroll
                            for (int r = 0; r < 4; ++r) {
                                const int j = F.wave + 8 * (r0 + r); const v4u raw = rawv[r];
                                float x[8]; x[0] = pg8::bflo(raw.x); x[1] = pg8::bfhi(raw.x); x[2] = pg8::bflo(raw.y); x[3] = pg8::bfhi(raw.y); x[4] = pg8::bflo(raw.z); x[5] = pg8::bfhi(raw.z); x[6] = pg8::bflo(raw.w); x[7] = pg8::bfhi(raw.w);
                                float s = 0.f;
#pragma unroll
                                for (int e = 0; e < 8; ++e) s += x[e];
                                const float mu = wave_sum(s) * (1.f / 512.f); float q = 0.f;
#pragma unroll
                                for (int e = 0; e < 8; ++e) { x[e] -= mu; q += x[e] * x[e]; }
                                const float rstd = 1.0f / sqrtf(wave_sum(q) * (1.f / 512.f) + EPS);
                                if ((F.lane >> 4) == g) {
                                    const f32x4 y0 = (f32x4){x[0], x[1], x[2], x[3]} * rstd * g0, y1 = (f32x4){x[4], x[5], x[6], x[7]} * rstd * g1;
                                    *(LAS v4u*)(VN + j * 272 + c0 * 2) = (v4u){pk2(y0.x, y0.y), pk2(y0.z, y0.w), pk2(y1.x, y1.y), pk2(y1.z, y1.w)};
                                    if (smp) { float* dp = dout + O_SV + (((size_t)l * NB + (ch - 128)) * 64 + j) * 512 + g * 128 + c0; *(f32x4*)dp = y0; *(f32x4*)(dp + 4) = y1; }
                                }
                            }
                        }
                    }
                    __syncthreads();
                    {
                        const int ctw = F.wave;
                        pg8::bf16x8 vfr[4];
#pragma unroll
                        for (int s2 = 0; s2 < 4; ++s2) {
                            if (32 * s2 < L) {
                                typedef short v4i16_t __attribute__((ext_vector_type(4)));
                                const int q_ = fr >> 2, p_ = F.lane & 3;
                                const v4i16_t lo = __builtin_amdgcn_ds_read_tr16_b64_v4i16((LAS v4i16_t*)(VN + (32 * s2 + 8 * fq + q_) * 272 + (16 * ctw + 4 * p_) * 2));
                                const v4i16_t hi = __builtin_amdgcn_ds_read_tr16_b64_v4i16((LAS v4i16_t*)(VN + (32 * s2 + 8 * fq + 4 + q_) * 272 + (16 * ctw + 4 * p_) * 2));
                                vfr[s2] = (pg8::bf16x8){lo[0], lo[1], lo[2], lo[3], hi[0], hi[1], hi[2], hi[3]};
                            } else vfr[s2] = (pg8::bf16x8){0, 0, 0, 0, 0, 0, 0, 0};
                        }
                        const size_t rb0 = (size_t)(m0 + fr) * ZP + g * 128 + 16 * ctw + 4 * fq;
                        const float* bp = ka->in[I_SGUB] + (l * 4 + g) * 128 + fr;
                        v2u uc = *(const GAS v2u*)(Z + rb0 + CU), gc = *(const GAS v2u*)(Z + rb0 + CGB); float bc = bp[0];
#pragma unroll
                        for (int rt = 0; rt < 8; ++rt) {
                            if (16 * rt < L) {
                                v2u un = uc, gn = gc; float bn = bc;
                                if (16 * (rt + 1) < L) { const size_t rbn = rb0 + (size_t)(16 * (rt + 1)) * ZP; un = *(const GAS v2u*)(Z + rbn + CU); gn = *(const GAS v2u*)(Z + rbn + CGB); bn = bp[16 * (rt + 1)]; }
                                pg8::f32x4 acc = {0.f, 0.f, 0.f, 0.f};
#pragma unroll
                                for (int s2 = 0; s2 < 4; ++s2) if (s2 <= (rt >> 1)) { const pg8::bf16x8 wf = *(const LAS pg8::bf16x8*)(WT + (16 * rt + fr) * 272 + (32 * s2 + 8 * fq) * 2); acc = __builtin_amdgcn_mfma_f32_16x16x32_bf16(vfr[s2], wf, acc, 0, 0, 0); }
                                v2u o; o.x = pk2(pg8::bflo(uc.x) * (acc[0] + bc) * siluf_(pg8::bflo(gc.x)), pg8::bfhi(uc.x) * (acc[1] + bc) * siluf_(pg8::bfhi(gc.x)));
                                o.y = pk2(pg8::bflo(uc.y) * (acc[2] + bc) * siluf_(pg8::bflo(gc.y)), pg8::bfhi(uc.y) * (acc[3] + bc) * siluf_(pg8::bfhi(gc.y)));
                                *(GAS v2u*)(Z + rb0 + (size_t)(16 * rt) * ZP + CGB) = o;
                                uc = un; gc = gn; bc = bn;
                            }
                        }
                    }
                    __syncthreads();
                }
            }
            {
                constexpr int PQ = 272;
                LAS unsigned char* QT = F.lds;
                LAS unsigned char* KT = F.lds + 64 * PQ;
                LAS float* tot = (LAS float*)(F.lds + 2 * 64 * PQ);
                const int d = F.tid & 127, tg = __builtin_amdgcn_readfirstlane(F.tid >> 7);
                for (int it = (F.vcu + 192) % F.G; it < 1056; it += F.G) {
                    const bool smp = it >= 1024; const int bh = smp ? it - 1024 : it >> 5, c = smp ? 0 : it & 31, bb = bh >> 2, h = bh & 3;
                    const int mb = (smp ? MP + bb * 64 : bb * SEQ) + c * 64;
                    float w2[16];
#pragma unroll
                    for (int r = 0; r < 16; ++r) w2[r] = ka->in[I_WA2][(size_t)l * 16 * 512 + r * 512 + h * 128 + d];
                    const float bad = ka->in[I_BA][l * 512 + h * 128 + d];
                    float bl[16], qv[16], kv[16]; float run = 0.f;
#pragma unroll
                    for (int i = 0; i < 16; ++i) {
                        const size_t m = (size_t)(mb + 16 * tg + i);
                        const float* zr = zlr + m * 16; float x = bad;
#pragma unroll
                        for (int r = 0; r < 16; ++r) x += zr[r] * w2[r];
                        const float ls = fminf(x, 0.f) - log1pf(__expf(-fabsf(x)));
                        run += ls * (1.0f / 16.0f); bl[i] = run;
                        qv[i] = bf2f(Z[m * ZP + CQ + h * 128 + d]); kv[i] = bf2f(Z[m * ZP + CK + h * 128 + d]);
                    }
                    tot[tg * 128 + d] = run;
                    asm volatile("s_waitcnt vmcnt(0)" ::: "memory");
                    __syncthreads();
                    float off = 0.f, total = 0.f;
#pragma unroll
                    for (int g2 = 0; g2 < 4; ++g2) { const float tv = tot[g2 * 128 + d]; total += tv; if (g2 < tg) off += tv; }
                    unsigned kp[8];
#pragma unroll
                    for (int i = 0; i < 16; ++i) {
                        const float b = off + bl[i]; const float eb = __expf(b);
                        const unsigned qb = f2bf(qv[i] * 0.08838834764831845f * eb), kb = f2bf(kv[i] * __expf(-b));
                        const int t = 16 * tg + i;
                        *(LAS bf16*)(QT + t * PQ + d * 2) = (bf16)qb; *(LAS bf16*)(KT + t * PQ + d * 2) = (bf16)kb;
                        Z[(size_t)(mb + t) * ZP + CQ + h * 128 + d] = (bf16)qb;
                        if (i & 1) kp[i >> 1] |= kb << 16; else kp[i >> 1] = kb;
                    }
                    {
                        bf16* kd = Z + (size_t)(mb + (d >> 1)) * ZP + CK + h * 128 + (d & 1) * 64 + 16 * tg;
                        *(v4u*)kd = (v4u){kp[0], kp[1], kp[2], kp[3]}; *(v4u*)(kd + 8) = (v4u){kp[4], kp[5], kp[6], kp[7]};
                    }
                    float* decg = (float*)(ws + WS_DEC) + (size_t)it * 128;
                    if (tg == 0) decg[d] = __expf(total);
                    __syncthreads();
                    {
                        const int lane = F.lane, rt = F.wave & 3, fr = lane & 15, fq = lane >> 4;
                        bf16* ab = (bf16*)(ws + WS_ABUF) + (size_t)it * 2560;
#pragma unroll
                        for (int cc = 0; cc < 2; ++cc) {
                            const int ct = 2 * (F.wave >> 2) + cc;
                            if (ct <= rt) {
                                pg8::f32x4 acc = {0.f, 0.f, 0.f, 0.f};
#pragma unroll
                                for (int s = 0; s < 4; ++s) {
                                    const pg8::bf16x8 kf = *(const LAS pg8::bf16x8*)(KT + (16 * ct + fr) * PQ + (32 * s + 8 * fq) * 2);
                                    const pg8::bf16x8 qf = *(const LAS pg8::bf16x8*)(QT + (16 * rt + fr) * PQ + (32 * s + 8 * fq) * 2);
                                    acc = __builtin_amdgcn_mfma_f32_16x16x32_bf16(kf, qf, acc, 0, 0, 0);
                                }
                                const int t = 16 * rt + fr, j0 = 16 * ct + 4 * fq;
                                v2u w;
                                w.x = pk2(j0 + 0 <= t ? acc[0] : 0.f, j0 + 1 <= t ? acc[1] : 0.f); w.y = pk2(j0 + 2 <= t ? acc[2] : 0.f, j0 + 3 <= t ? acc[3] : 0.f);
                                *(v2u*)(ab + (rt * (rt + 1) / 2 + ct) * 256 + fr * 16 + 4 * fq) = w;
                            }
                        }
                    }
                    __syncthreads();
                }
            }
            GRID_BAR();
        }
        if (KON(9) && IN(pb + 2)) {
        PHASE_BEGIN();
            constexpr int SB_A = 0, SB_Q = 9216, SB_KT = 26624, SB_V = 45056, SB_DEC = 50176, SB_SZ = 50688, SB_ST = 2 * SB_SZ, ST_SZ = 8704;
            constexpr int PA = 144, PQ2 = 272, PK = 144, PV = 80, PS = 272;
            const int tid = F.tid, lane = F.lane, fr = lane & 15, fq = lane >> 4;
            const int ct = F.wave & 1, rto = F.wave >> 1;
            for (int u = tid; u < 2 * SB_SZ / 16; u += 512) *(LAS v4u*)(F.lds + u * 16) = (v4u){0u, 0u, 0u, 0u};
            __syncthreads();
            for (int it = F.vcu; it < 512; it += F.G) {
                const bool smp = it >= 256; const int id = it & 255, bh = id >> 3, sl = id & 7, bb = bh >> 2, h = bh & 3;
                const int nch = smp ? 1 : 32, m0 = smp ? MP + bb * 64 : bb * SEQ, item0 = smp ? 1024 + bh : bh * 32;
                const int dvc = h * 256 + 32 * sl;
                pg8::f32x4 accS[2];
                float* sout = dout + (smp ? O_GS : O_GP) + (((size_t)l * NB + bb) * 4 + h) * 128 * 256 + 32 * sl + 16 * ct + fr;
                if (smp) {
                    const float* s0 = ka->in[I_SGLA] + (((size_t)l * NB + bb) * 4 + h) * 128 * 256 + 32 * sl + 16 * ct + fr;
#pragma unroll
                    for (int k2 = 0; k2 < 2; ++k2)
#pragma unroll
                        for (int i = 0; i < 4; ++i) accS[k2][i] = s0[(size_t)(16 * (2 * rto + k2) + 4 * fq + i) * 256];
                } else { accS[0] = (pg8::f32x4){0.f, 0.f, 0.f, 0.f}; accS[1] = accS[0]; }
                v4u rA, rQ0, rQ1, rK0, rK1, rV; float rD;
                const int a_tau = tid >> 5, a_rt = (a_tau >= 6) ? 3 : (a_tau >= 3) ? 2 : (a_tau >= 1) ? 1 : 0, a_ct = a_tau - a_rt * (a_rt + 1) / 2, a_p = tid & 31;
#define SC_LOAD(cidx) do { const int mb_ = m0 + 64 * (cidx); const size_t itm_ = (size_t)(item0 + (cidx)); \
                    if (tid < 320) rA = *(const GAS v4u*)((const bf16*)(ws + WS_ABUF) + itm_ * 2560 + tid * 8); \
                    rQ0 = *(const GAS v4u*)(Z + (size_t)(mb_ + (tid >> 4)) * ZP + CQ + h * 128 + 8 * (tid & 15)); \
                    rQ1 = *(const GAS v4u*)(Z + (size_t)(mb_ + 32 + (tid >> 4)) * ZP + CQ + h * 128 + 8 * (tid & 15)); \
                    rK0 = *(const GAS v4u*)(Z + (size_t)(mb_ + (tid >> 4)) * ZP + CK + h * 128 + 8 * (tid & 15)); \
                    rK1 = *(const GAS v4u*)(Z + (size_t)(mb_ + 32 + (tid >> 4)) * ZP + CK + h * 128 + 8 * (tid & 15)); \
                    if (tid < 256) rV = *(const GAS v4u*)(Z + (size_t)(mb_ + (tid >> 2)) * ZP + CVC + dvc + 8 * (tid & 3)); \
                    if (tid < 128) rD = ((const float*)(ws + WS_DEC))[itm_ * 128 + tid]; } while (0)
#define SC_STORE(bufi) do { LAS unsigned char* B_ = F.lds + (bufi) * SB_SZ; \
                    if (tid < 320) *(LAS v4u*)(B_ + SB_A + (16 * a_rt + (a_p >> 1)) * PA + (16 * a_ct + 8 * (a_p & 1)) * 2) = rA; \
                    *(LAS v4u*)(B_ + SB_Q + (tid >> 4) * PQ2 + (tid & 15) * 16) = rQ0; *(LAS v4u*)(B_ + SB_Q + (32 + (tid >> 4)) * PQ2 + (tid & 15) * 16) = rQ1; \
                    { const int r0_ = tid >> 4, p_ = tid & 15; \
                      *(LAS v4u*)(B_ + SB_KT + (2 * r0_ + (p_ >> 3)) * PK + (p_ & 7) * 16) = rK0; *(LAS v4u*)(B_ + SB_KT + (2 * (32 + r0_) + (p_ >> 3)) * PK + (p_ & 7) * 16) = rK1; } \
                    if (tid < 256) *(LAS v4u*)(B_ + SB_V + (tid >> 2) * PV + (tid & 3) * 16) = rV; \
                    if (tid < 128) *(LAS float*)(B_ + SB_DEC + tid * 4) = rD; } while (0)
#define SC_PUBLISH(sti) do { LAS unsigned char* S_ = F.lds + SB_ST + (sti) * ST_SZ; \
                    _Pragma("unroll") for (int k2 = 0; k2 < 2; ++k2) { v2u w_; w_.x = pk2(accS[k2][0], accS[k2][1]); w_.y = pk2(accS[k2][2], accS[k2][3]); \
                        *(LAS v2u*)(S_ + (16 * ct + fr) * PS + (16 * (2 * rto + k2) + 4 * fq) * 2) = w_; } } while (0)
                SC_LOAD(0);
                SC_STORE(0);
                SC_PUBLISH(0);
                __syncthreads();
                for (int c = 0; c < nch; ++c) {
                    const int cb = c & 1;
                    if (c + 1 < nch) SC_LOAD(c + 1);
                    asm volatile("" ::: "memory");
                    LAS unsigned char* B = F.lds + cb * SB_SZ; LAS unsigned char* ST = F.lds + SB_ST + cb * ST_SZ;
                    pg8::bf16x8 vf[2];
#pragma unroll
                    for (int s = 0; s < 2; ++s) {
                        typedef short v4i16_t __attribute__((ext_vector_type(4)));
                        const int q_ = fr >> 2, p_ = lane & 3;
                        const v4i16_t lo = __builtin_amdgcn_ds_read_tr16_b64_v4i16((LAS v4i16_t*)(B + SB_V + (32 * s + 8 * fq + q_) * PV + (16 * ct + 4 * p_) * 2));
                        const v4i16_t hi = __builtin_amdgcn_ds_read_tr16_b64_v4i16((LAS v4i16_t*)(B + SB_V + (32 * s + 8 * fq + 4 + q_) * PV + (16 * ct + 4 * p_) * 2));
                        vf[s] = (pg8::bf16x8){lo[0], lo[1], lo[2], lo[3], hi[0], hi[1], hi[2], hi[3]};
                    }
                    pg8::f32x4 ao = {0.f, 0.f, 0.f, 0.f};
#pragma unroll
                    for (int s = 0; s < 2; ++s) {
                        const pg8::bf16x8 af = *(const LAS pg8::bf16x8*)(B + SB_A + (16 * rto + fr) * PA + (32 * s + 8 * fq) * 2);
                        ao = __builtin_amdgcn_mfma_f32_16x16x32_bf16(vf[s], af, ao, 0, 0, 0);
                    }
#pragma unroll
                    for (int s = 0; s < 4; ++s) {
                        const pg8::bf16x8 sf = *(const LAS pg8::bf16x8*)(ST + (16 * ct + fr) * PS + (32 * s + 8 * fq) * 2);
                        const pg8::bf16x8 qf = *(const LAS pg8::bf16x8*)(B + SB_Q + (16 * rto + fr) * PQ2 + (32 * s + 8 * fq) * 2);
                        ao = __builtin_amdgcn_mfma_f32_16x16x32_bf16(sf, qf, ao, 0, 0, 0);
                    }
                    {
                        v2u w; w.x = pk2(ao[0], ao[1]); w.y = pk2(ao[2], ao[3]);
                        *(GAS v2u*)(Z + (size_t)(m0 + 64 * c + 16 * rto + fr) * ZP + CVC + dvc + 16 * ct + 4 * fq) = w;
                    }
#pragma unroll
                    for (int k2 = 0; k2 < 2; ++k2) {
                        const int rt = 2 * rto + k2;
#pragma unroll
                        for (int s = 0; s < 2; ++s) {
                            const pg8::bf16x8 kf = *(const LAS pg8::bf16x8*)(B + SB_KT + (16 * rt + fr) * PK + (32 * s + 8 * fq) * 2);
                            accS[k2] = __builtin_amdgcn_mfma_f32_16x16x32_bf16(kf, vf[s], accS[k2], 0, 0, 0);
                        }
                        const pg8::f32x4 dc = *(const LAS pg8::f32x4*)(B + SB_DEC + (16 * rt + 4 * fq) * 4);
                        accS[k2] = accS[k2] * dc;
                    }
                    SC_PUBLISH(cb ^ 1);
                    asm volatile("" ::: "memory");
                    if (c + 1 < nch) SC_STORE(cb ^ 1);
                    __syncthreads();
                }
#pragma unroll
                for (int k2 = 0; k2 < 2; ++k2)
#pragma unroll
                    for (int i = 0; i < 4; ++i) sout[(size_t)(16 * (2 * rto + k2) + 4 * fq + i) * 256] = accS[k2][i];
#undef SC_LOAD
#undef SC_STORE
#undef SC_PUBLISH
            }
            GRID_BAR();
        }
        if (KON(4) && IN(pb + 3)) {
        PHASE_BEGIN();
            for (int m = 2 * gw; m < MT; m += 2 * NGW) {
                v2u raw[8], graw[8]; float ss[8];
#pragma unroll
                for (int q = 0; q < 8; ++q) { const size_t rb = (size_t)(m + (q >> 2)) * ZP + (q & 3) * 256 + 4 * F.lane; raw[q] = *(const GAS v2u*)(Z + rb + CVC); graw[q] = *(const GAS v2u*)(Z + rb + CGC); }
                const f32x4 gg = *(const f32x4*)(ka->in[I_GLAG] + l * 256 + 4 * F.lane);
#pragma unroll
                for (int q = 0; q < 8; ++q) { const float o0 = pg8::bflo(raw[q].x), o1 = pg8::bfhi(raw[q].x), o2 = pg8::bflo(raw[q].y), o3 = pg8::bfhi(raw[q].y); ss[q] = wave_sum((o0 * o0 + o1 * o1) + (o2 * o2 + o3 * o3)); }
#pragma unroll
                for (int q = 0; q < 8; ++q) {
                    const float rstd = 1.0f / sqrtf(ss[q] * (1.f / 256.f) + EPS);
                    v2u w; w.x = pk2(pg8::bflo(raw[q].x) * rstd * gg.x * siluf_(pg8::bflo(graw[q].x)), pg8::bfhi(raw[q].x) * rstd * gg.y * siluf_(pg8::bfhi(graw[q].x)));
                    w.y = pk2(pg8::bflo(raw[q].y) * rstd * gg.z * siluf_(pg8::bflo(graw[q].y)), pg8::bfhi(raw[q].y) * rstd * gg.w * siluf_(pg8::bfhi(graw[q].y)));
                    *(GAS v2u*)(Z + (size_t)(m + (q >> 2)) * ZP + CVC + (q & 3) * 256 + 4 * F.lane) = w;
                }
            }
            GRID_BAR();
        }
        if (KON(5) && IN(pb + 4)) {
        PHASE_BEGIN();
            pg8::Gemm g{XN, W1 + (size_t)N1A * 1024, 1024, 1024, 1024}; pg8::StaticOrder S; S.init(MP / 256, N1B / 256, F.G, (int)blockIdx.x);
            pg8::EpiGm E{Z, ZP};
            pg8::gemm_phase<pg8::EpiGm, pg8::StaticOrder, true>(F.lds, g, S, E);
            GRID_BAR();
        }
        if (KON(6) && IN(pb + 5)) {
        PHASE_BEGIN();
            bf16* MB = (bf16*)(ws + WS_MB);
            {
                const int rp = F.vcu >> 4, cp = F.vcu & 15, ms0 = MP + 32 * rp, n0 = 64 * cp;
                const int r = F.lane & 31, h = F.lane >> 5, ctw = F.wave & 1, kq = F.wave >> 1, br = kq < 2 ? kq : 2;
                const f32x16 acc = piece_mma<512>(Z + (size_t)(ms0 + r) * ZP + CY + 512 * kq + 64 * h, (const bf16*)(ws + WS_WCAT) + (size_t)l * 1024 * 2048 + (size_t)(n0 + 32 * ctw + r) * 2048 + 512 * kq + 64 * h);
                LAS float* red = (LAS float*)F.lds;
                const bf16* gp = (const bf16*)(ws + WS_GMS) + (size_t)(ms0 - MP + r) * 3072 + br * 1024 + n0 + 32 * ctw + 4 * h;
#pragma unroll
                for (int q = 0; q < 4; ++q) {
                    const v2u g = *(const GAS v2u*)(gp + 8 * q);
                    const f32x4 pv = {acc[4 * q] * pg8::bflo(g.x), acc[4 * q + 1] * pg8::bfhi(g.x), acc[4 * q + 2] * pg8::bflo(g.y), acc[4 * q + 3] * pg8::bfhi(g.y)};
                    *(LAS f32x4*)(red + (F.wave * 32 + r) * 32 + 8 * q + 4 * h) = pv;
                }
                __syncthreads();
                { const int c2 = F.tid >> 8, tok = (F.tid >> 3) & 31, n4 = (F.tid & 7) * 4; f32x4 s = {0.f, 0.f, 0.f, 0.f};
#pragma unroll
                    for (int k2 = 0; k2 < 4; ++k2) s += *(const LAS f32x4*)(red + ((2 * k2 + c2) * 32 + tok) * 32 + n4);
                    v2u o; o.x = pk2(s.x, s.y); o.y = pk2(s.z, s.w);
                    *(GAS v2u*)(MB + (size_t)(ms0 + tok) * 1024 + n0 + 32 * c2 + n4) = o; }
                __syncthreads();
            }
            pg8::Gemm g{Z + CY, (const bf16*)(ws + WS_WCAT) + (size_t)l * 1024 * 2048, ZP, 2048, 2048}; pg8::StaticOrder S; S.init(MP / 256, 4, F.G, (int)blockIdx.x);
            pg8::EpiMerge E{Z, ZP, MB, 1024};
            pg8::gemm_phase<pg8::EpiMerge, pg8::StaticOrder, true>(F.lds, g, S, E);
            GRID_BAR();
        }
        if (KON(7) && IN(pb + 6)) {
        PHASE_BEGIN();
            const bf16* MB = (const bf16*)(ws + WS_MB);
            {
                const int rp = F.vcu >> 4, cp = F.vcu & 15, ms0 = MP + 32 * rp, n0 = 64 * cp;
                const int r = F.lane & 31, h = F.lane >> 5, ctw = F.wave & 1, kq = F.wave >> 1;
                const f32x16 acc = piece_mma<256>(MB + (size_t)(ms0 + r) * 1024 + 256 * kq + 64 * h, (const bf16*)(ws + WS_WOUT) + (size_t)l * 1024 * 1024 + (size_t)(n0 + 32 * ctw + r) * 1024 + 256 * kq + 64 * h);
                LAS float* red = (LAS float*)F.lds; LAS unsigned* flag = (LAS unsigned*)(F.lds + 40960);
                float* OUTS = (float*)(ws + WS_OUTS);
#pragma unroll
                for (int q = 0; q < 4; ++q) *(LAS f32x4*)(red + (F.wave * 32 + r) * 32 + 8 * q + 4 * h) = (f32x4){acc[4 * q], acc[4 * q + 1], acc[4 * q + 2], acc[4 * q + 3]};
                __syncthreads();
                { const int c2 = F.tid >> 8, tok = (F.tid >> 3) & 31, n4 = (F.tid & 7) * 4; f32x4 s = {0.f, 0.f, 0.f, 0.f};
#pragma unroll
                    for (int k2 = 0; k2 < 4; ++k2) s += *(const LAS f32x4*)(red + ((2 * k2 + c2) * 32 + tok) * 32 + n4);
                    *(GAS f32x4*)(OUTS + (size_t)(ms0 - MP + tok) * 1024 + n0 + 32 * c2 + n4) = s; }
                asm volatile("s_waitcnt vmcnt(0)" ::: "memory");
                __syncthreads();
                if (F.tid == 0) {
                    __builtin_amdgcn_fence(__ATOMIC_RELEASE, "agent");
                    asm volatile("s_waitcnt vmcnt(0)" ::: "memory");
                    const unsigned old = __hip_atomic_fetch_add((unsigned*)(ws + WS_CTL) + CW_SPAN + 64 * (16 * l + rp), 1u, __ATOMIC_RELAXED, __HIP_MEMORY_SCOPE_AGENT);
                    if (old == 15u) { __builtin_amdgcn_fence(__ATOMIC_ACQUIRE, "agent"); asm volatile("s_waitcnt vmcnt(0)" ::: "memory"); }
                    *flag = (old == 15u) ? 1u : 0u;
                }
                __syncthreads();
                if (*flag) {
#pragma unroll 1
                    for (int i = 0; i < 2; ++i) {
                        const int m = ms0 + 4 * F.wave + 2 * i;
                        const float* xprev = (l == 0) ? ka->in[I_XS] + (size_t)(m - MP) * DM : dout + (size_t)m * DM;
                        rowpost2(OUTS + (size_t)(m - MP) * DM, xprev, mod_l + (size_t)batch_of_row(m) * 3072, ka->in[I_POSTG] + l * 1024, dout + (size_t)m * DM, l + 1 < DEPTH,
                                 mod_all + ((size_t)(l + 1 < DEPTH ? l + 1 : l) * 16 + batch_of_row(m)) * 3072, ka->in[I_PREG] + (l + 1 < DEPTH ? l + 1 : l) * 1024, XN + (size_t)m * DM, F.lane);
                    }
                }
                __syncthreads();
            }
            pg8::Gemm g{MB, (const bf16*)(ws + WS_WOUT) + (size_t)l * 1024 * 1024, 1024, 1024, 1024}; pg8::StaticOrder S; S.init(MP / 256, 4, F.G, (int)blockIdx.x);
            pg8::EpiF32 E{OUTF, 1024};
            pg8::gemm_phase<pg8::EpiF32, pg8::StaticOrder, true>(F.lds, g, S, E);
            GRID_BAR();
        }
        if (KON(8) && IN(pb + 7)) {
        PHASE_BEGIN();
            for (int m = 2 * gw; m < MP; m += 2 * NGW) {
                const float* xprev = (l == 0) ? ka->in[I_XP] + (size_t)m * DM : dout + (size_t)m * DM;
                rowpost2(OUTF + (size_t)m * DM, xprev, mod_l + (size_t)batch_of_row(m) * 3072, ka->in[I_POSTG] + l * 1024, dout + (size_t)m * DM, l + 1 < DEPTH,
                         mod_all + ((size_t)(l + 1 < DEPTH ? l + 1 : l) * 16 + batch_of_row(m)) * 3072, ka->in[I_PREG] + (l + 1 < DEPTH ? l + 1 : l) * 1024, XN + (size_t)m * DM, F.lane);
            }
            if (l + 1 < DEPTH) GRID_BAR();
        }
    }
#undef IN
#undef GRID_BAR
#undef mod_all
#undef zlr
#undef wlr_all
#undef XN
#undef Z
#undef OUTF
}

extern "C" void kernel_launch(void* const* d_in, const int* in_sizes, int n_in, void* d_out, int out_size, void* d_ws, size_t ws_size, hipStream_t stream) {
    static int grid = 0;
    if (grid == 0) {
        if (n_in != N_IN || out_size != (int)O_END || ws_size < WS_END) { fprintf(stderr, "kernel_launch: unexpected shapes: n_in %d out %d ws %zu (need %zu)\n", n_in, out_size, ws_size, (size_t)WS_END); grid = -1; return; }
        int dev = 0, cus = 0;
        if (hipGetDevice(&dev) != hipSuccess || hipDeviceGetAttribute(&cus, hipDeviceAttributeMultiprocessorCount, dev) != hipSuccess) { grid = -1; return; }
        if (hipFuncSetAttribute((const void*)mk_fwd, hipFuncAttributeMaxDynamicSharedMemorySize, LDS_BYTES) != hipSuccess) { grid = -1; return; }
        grid = cus;
    }
    if (grid < 0) return;
    (void)hipMemsetAsync((char*)d_ws + WS_CTL, 0, CTL_ZERO_BYTES, stream);
    Args a{};
    for (int i = 0; i < N_IN; ++i) a.in[i] = (const float*)d_in[i];
    a.out = (float*)d_out; a.ws = (unsigned char*)d_ws;
#if MK_N_LAUNCHES == 1
    a.ph_lo = 0; a.ph_hi = NPH; a.li = 0;
    hipLaunchKernelGGL(mk_fwd, dim3(grid), dim3(NWAVES * 64), LDS_BYTES, stream, a);
#else
#ifndef DUP_LO
#define DUP_LO 0
#define DUP_HI 0
#endif
    for (int p = 0; p < NPH; ++p) {
        a.ph_lo = p; a.ph_hi = p + 1; a.li = p; hipLaunchKernelGGL(mk_fwd, dim3(grid), dim3(NWAVES * 64), LDS_BYTES, stream, a);
        if (p + 1 == DUP_HI) for (int q = DUP_LO; q < DUP_HI; ++q) { a.ph_lo = q; a.ph_hi = q + 1; a.li = q; hipLaunchKernelGGL(mk_fwd, dim3(grid), dim3(NWAVES * 64), LDS_BYTES, stream, a); }
    }
#endif
}
```
